# Optimizing an MI355X kernel written in HIP

```python
import jax, jax.numpy as jnp
from jax import lax
import numpy as np

D_MODEL = 1024
BATCH = 4
SEQ = 8192
DEPTH = 1
DEC_BATCH = 32
DEC_SEQ = 64
PAST_LEN = 2048

CHUNK = 64
N_META = 16
D_CONV = D_MODEL // 2
CONV_WIDTH = 3
RET_HEADS = 4
RET_HEAD_DIM = 128
D_RET = RET_HEADS * RET_HEAD_DIM
D_MIX = D_CONV + D_RET
D_FF = 4 * D_MODEL
ROPE_BASE = 10000.0
NORM_EPS = 1e-6
GN_EPS = 1e-5
D_IN = 3 * D_CONV + 4 * D_RET
IN_SPLITS = (D_CONV, 2 * D_CONV, 3 * D_CONV, 3 * D_CONV + D_RET, 3 * D_CONV + 2 * D_RET, 3 * D_CONV + 3 * D_RET)

kernel_name = "hymba_shortconv_retnet_stream_step"


def rmsnorm(x, w):
    xf = x.astype(jnp.float32)
    y = xf * lax.rsqrt(jnp.mean(xf * xf, axis=-1, keepdims=True) + NORM_EPS)
    return (y * w.astype(jnp.float32)).astype(x.dtype)


def rotary(x, pos):
    half = RET_HEAD_DIM // 2
    inv_freq = ROPE_BASE ** (-jnp.arange(half, dtype=jnp.float32) / half)
    ang = pos[:, None] * inv_freq[None, :]
    cos = jnp.cos(ang)[None, :, None, :]
    sin = jnp.sin(ang)[None, :, None, :]
    x1, x2 = x[..., :half], x[..., half:]
    return jnp.concatenate([x1 * cos - x2 * sin, x1 * sin + x2 * cos], axis=-1)


def retention_log_gamma():
    return jnp.log(1.0 - 2.0 ** (-5.0 - jnp.arange(RET_HEADS, dtype=jnp.float32)))


def retention_block(q, k, v, s, log_gamma):
    L = q.shape[1]
    idx = jnp.arange(L, dtype=jnp.float32)
    diff = idx[:, None] - idx[None, :]
    decay = jnp.where(diff[None] >= 0,
                      jnp.exp(jnp.maximum(diff, 0.0)[None] * log_gamma[:, None, None]), 0.0)
    scores = jnp.einsum("bihd,bjhd->bhij", q, k) * decay[None]
    inner = jnp.einsum("bhij,bjhe->bihe", scores, v)
    cross_decay = jnp.exp((idx + 1.0)[:, None] * log_gamma[None, :])
    cross = jnp.einsum("bihd,bhde->bihe", q, s) * cross_decay[None, :, :, None]
    k_decay = jnp.exp((L - 1.0 - idx)[:, None] * log_gamma[None, :])
    s_new = jnp.exp(L * log_gamma)[None, :, None, None] * s + jnp.einsum(
        "bjhd,bjhe,jh->bhde", k, v, k_decay)
    return inner + cross, s_new


def retention_seq(q, k, v, s, lead):
    log_gamma = retention_log_gamma()
    outs = []
    if lead > 0:
        o, s = retention_block(q[:, :lead], k[:, :lead], v[:, :lead], s, log_gamma)
        outs.append(o)
        q, k, v = q[:, lead:], k[:, lead:], v[:, lead:]
    bsz, T = q.shape[0], q.shape[1]
    if T <= CHUNK:
        o, s = retention_block(q, k, v, s, log_gamma)
        outs.append(o)
    else:
        nc = T // CHUNK

        def to_chunks(a):
            return a.reshape(bsz, nc, CHUNK, RET_HEADS, RET_HEAD_DIM).transpose(1, 0, 2, 3, 4)

        def step(state, qkv):
            qc, kc, vc = qkv
            oc, state = retention_block(qc, kc, vc, state, log_gamma)
            return state, oc

        s, o = lax.scan(step, s, (to_chunks(q), to_chunks(k), to_chunks(v)))
        outs.append(o.transpose(1, 0, 2, 3, 4).reshape(bsz, T, RET_HEADS, RET_HEAD_DIM))
    o = jnp.concatenate(outs, axis=1) if len(outs) > 1 else outs[0]
    return o, s


def hybrid_layer(h, pos, conv_hist, ret_state, lead,
                 norm_mix_w, w_in, conv_w, ret_gn_w, w_out, norm_ffn_w, w_up, w_down):
    bsz, T, _ = h.shape
    hn = rmsnorm(h, norm_mix_w)
    proj = hn @ w_in
    xt, b_gate, c_gate, q, k, v, g = jnp.split(proj, IN_SPLITS, axis=-1)
    ucat = jnp.concatenate([conv_hist.astype(h.dtype), c_gate * xt], axis=1)
    conv_y = conv_w[0] * ucat[:, :T] + conv_w[1] * ucat[:, 1:T + 1] + conv_w[2] * ucat[:, 2:]
    conv_out = b_gate * conv_y
    new_hist = ucat[:, T:]
    def heads(a):
        return a.astype(jnp.float32).reshape(bsz, T, RET_HEADS, RET_HEAD_DIM)
    qh = rotary(heads(q), pos)
    kh = rotary(heads(k), pos) * (RET_HEAD_DIM ** -0.5)
    vh = heads(v)
    o, new_state = retention_seq(qh, kh, vh, ret_state.astype(jnp.float32), lead)
    mu = jnp.mean(o, axis=-1, keepdims=True)
    var = jnp.mean(jnp.square(o - mu), axis=-1, keepdims=True)
    o = ((o - mu) * lax.rsqrt(var + GN_EPS)).reshape(bsz, T, D_RET) * ret_gn_w.astype(jnp.float32)
    ret_out = (jax.nn.silu(g.astype(jnp.float32)) * o).astype(h.dtype)
    h = h + jnp.concatenate([conv_out, ret_out], axis=-1) @ w_out
    f = jnp.square(jax.nn.relu(rmsnorm(h, norm_ffn_w) @ w_up)) @ w_down
    return h + f, new_hist, new_state.astype(h.dtype)


def setup_inputs(seed: int = 0) -> dict:
    key = jax.random.key(seed)
    ks = jax.random.split(key, 14)
    f32 = jnp.float32
    return {
        "x_prompt": jax.random.normal(ks[0], (BATCH, SEQ, D_MODEL), f32),
        "x_sample": jax.random.normal(ks[1], (DEC_BATCH, DEC_SEQ, D_MODEL), f32),
        "state_conv": jax.random.normal(ks[2], (DEPTH, DEC_BATCH, CONV_WIDTH - 1, D_CONV), f32),
        "state_ret": 0.5 * jax.random.normal(ks[3], (DEPTH, DEC_BATCH, RET_HEADS, RET_HEAD_DIM, RET_HEAD_DIM), f32),
        "meta_tokens": jax.random.normal(ks[4], (N_META, D_MODEL), f32),
        "norm_mix_w": 1.0 + 0.02 * jax.random.normal(ks[5], (DEPTH, D_MODEL), f32),
        "w_in": jax.random.normal(ks[6], (DEPTH, D_MODEL, D_IN), f32) * D_MODEL ** -0.5,
        "conv_w": jax.random.normal(ks[7], (DEPTH, CONV_WIDTH, D_CONV), f32) * CONV_WIDTH ** -0.5,
        "ret_gn_w": 1.0 + 0.02 * jax.random.normal(ks[8], (DEPTH, D_RET), f32),
        "w_out": jax.random.normal(ks[9], (DEPTH, D_MIX, D_MODEL), f32) * D_MIX ** -0.5,
        "norm_ffn_w": 1.0 + 0.02 * jax.random.normal(ks[10], (DEPTH, D_MODEL), f32),
        "w_up": jax.random.normal(ks[11], (DEPTH, D_MODEL, D_FF), f32) * D_MODEL ** -0.5,
        "w_down": jax.random.normal(ks[12], (DEPTH, D_FF, D_MODEL), f32) * D_FF ** -0.5,
        "norm_final_w": 1.0 + 0.02 * jax.random.normal(ks[13], (D_MODEL,), f32),
    }


def reference(x_prompt, x_sample, state_conv, state_ret, meta_tokens, norm_mix_w, w_in, conv_w,
              ret_gn_w, w_out, norm_ffn_w, w_up, w_down, norm_final_w):
    bp = x_prompt.shape[0]
    meta = jnp.broadcast_to(meta_tokens[None].astype(x_prompt.dtype), (bp, N_META, D_MODEL))
    hp = jnp.concatenate([meta, x_prompt], axis=1)
    pos_p = jnp.arange(hp.shape[1], dtype=jnp.float32) - float(N_META)
    hs = x_sample
    pos_s = jnp.arange(x_sample.shape[1], dtype=jnp.float32) + float(PAST_LEN)
    zero_hist = jnp.zeros((bp, CONV_WIDTH - 1, D_CONV), x_prompt.dtype)
    zero_ret = jnp.zeros((bp, RET_HEADS, RET_HEAD_DIM, RET_HEAD_DIM), jnp.float32)
    conv_p, ret_p, conv_s, ret_s = [], [], [], []
    for l in range(DEPTH):
        params = (norm_mix_w[l], w_in[l], conv_w[l], ret_gn_w[l], w_out[l], norm_ffn_w[l], w_up[l], w_down[l])
        hp, cp, rp = hybrid_layer(hp, pos_p, zero_hist, zero_ret, N_META, *params)
        hs, cs, rs = hybrid_layer(hs, pos_s, state_conv[l], state_ret[l], 0, *params)
        conv_p.append(cp)
        ret_p.append(rp)
        conv_s.append(cs)
        ret_s.append(rs)
    y_prompt = rmsnorm(hp[:, N_META:], norm_final_w)
    y_sample = rmsnorm(hs, norm_final_w)
    return (y_prompt, y_sample, jnp.stack(conv_p), jnp.stack(ret_p), jnp.stack(conv_s), jnp.stack(ret_s))
```

```cpp
#include <hip/hip_runtime.h>
#include <cstdio>
#include <cstdint>
namespace pg8 {
#define PG8_LAS __attribute__((address_space(3)))
typedef unsigned short bf16_t;
typedef short bf16x8 __attribute__((ext_vector_type(8)));
typedef float f32x4 __attribute__((ext_vector_type(4)));
typedef unsigned u32x4 __attribute__((ext_vector_type(4)));
constexpr int BM = 256, BK = 64, HALF = 128, HTB = HALF * BK * 2  , STAGE_BYTES = 8 * HTB, NXCD = 8, WGM = 8;

__host__ __device__ __forceinline__ int lds_byte(int r, int c) { const int st = (r >> 4) * 2 + (c >> 5), rr = r & 15, cc = c & 31, ob = rr * 64 + cc * 2; return st * 1024 + (ob ^ (((ob >> 9) & 1) << 5)); }
__host__ __device__ __forceinline__ void stage_rc(int b, int& R, int& C) { const int st = b / 1024, sb = b % 1024, swz = sb ^ (((sb >> 9) & 1) << 5); R = (st >> 1) * 16 + swz / 64; C = (st & 1) * 32 + (swz % 64) / 2; }
__host__ __device__ __forceinline__ int perm32(int rho) { const int n = rho >> 4, i = rho & 15; return 8 * (i >> 2) + 4 * n + (i & 3); }

struct Unit { int pm, pn; };
struct Gemm { const bf16_t* A; const bf16_t* Bt; int M, N, K; };

struct StaticOrder {
    int nM, nN, nwg, G, c;
    __host__ __device__ void init(int M, int N, int G_, int c_) { nM = M / BM; nN = N / BM; nwg = nM * nN; G = G_; c = c_; }
    __host__ __device__ bool next(int i, Unit& u) const {
        const long L = (long)i * G + c; if (L >= nwg) return false;
        int wgid = (int)L; { const int q = nwg / NXCD, r = nwg % NXCD, xcd = wgid % NXCD, off = wgid / NXCD; wgid = (xcd < r ? xcd * (q + 1) : r * (q + 1) + (xcd - r) * q) + off; }
        const int nig = WGM * nN, gid = wgid / nig, fm = gid * WGM, gsz = (nM - fm) < WGM ? (nM - fm) : WGM;
        u.pm = fm + ((wgid % nig) % gsz); u.pn = (wgid % nig) / gsz; return true;
    }
    __device__ __forceinline__ void a_ready(const Unit&) const {}
    __device__ __forceinline__ void done(const Unit&) const {}
};

__device__ __forceinline__ unsigned cvt_pk_bf16(float lo, float hi) { unsigned r; asm volatile("v_cvt_pk_bf16_f32 %0, %1, %2" : "=v"(r) : "v"(lo), "v"(hi)); return r; }
typedef float f32x2 __attribute__((ext_vector_type(2)));
typedef float f32x2v __attribute__((ext_vector_type(2)));
typedef unsigned u32x2 __attribute__((ext_vector_type(2)));
constexpr int ROWS_P = 32768;
__device__ __forceinline__ int row_pos(int r) { return r < ROWS_P ? (r & 8191) : 2048 + (r & 63); }
__device__ __forceinline__ float silu_f(float x) { return x * __builtin_amdgcn_rcpf(1.0f + __builtin_amdgcn_exp2f(-1.4426950408889634f * x)); }

struct EpiIn {
    static constexpr bool PERM = true, AFTER_DRAIN = false;
    bf16_t* base; const float* rstd; const float* rope;
    static constexpr size_t REG = (size_t)34816 * 512;
    __device__ __forceinline__ void operator()(const f32x4 (&acc)[2][2][4][2], const Unit& u, int wr, int wc, int fr, int fq) const {
        const int pn = u.pn, lc0 = wc * 32 + 8 * fq;
        const int rbase = u.pm * BM + wr * 64 + fr;
        if (pn < 4) {
#pragma unroll
            for (int ai = 0; ai < 2; ++ai)
#pragma unroll
                for (int m = 0; m < 4; ++m) { const int r = rbase + ai * HALF + m * 16; const float rs = rstd[r], rs2 = rs * rs;
                    const f32x4 a0 = acc[ai][0][m][0] * acc[ai][1][m][0] * rs2, a1 = acc[ai][0][m][1] * acc[ai][1][m][1] * rs2;
                    u32x4 w; w.x = cvt_pk_bf16(a0[0], a0[1]); w.y = cvt_pk_bf16(a0[2], a0[3]); w.z = cvt_pk_bf16(a1[0], a1[1]); w.w = cvt_pk_bf16(a1[2], a1[3]);
                    *(u32x4*)(base + (size_t)r * 512 + pn * 128 + lc0) = w; }
        } else if (pn >= 6 && pn < 10) {
            bf16_t* dst = base + (size_t)(2 + ((pn - 6) >> 1)) * REG; const int head = 2 * ((pn - 6) & 1) + (lc0 >> 6), i0 = lc0 & 63;
#pragma unroll
            for (int ai = 0; ai < 2; ++ai)
#pragma unroll
                for (int m = 0; m < 4; ++m) { const int r = rbase + ai * HALF + m * 16; const float rs = rstd[r];
                    const f32x4* cs = (const f32x4*)(rope + ((size_t)row_pos(r) * 64 + i0) * 2);
                    const f32x4 c0 = cs[0], c1 = cs[1], c2 = cs[2], c3 = cs[3];
                    const f32x4 x1a = acc[ai][0][m][0] * rs, x1b = acc[ai][0][m][1] * rs, x2a = acc[ai][1][m][0] * rs, x2b = acc[ai][1][m][1] * rs;
                    float o1[8], o2[8];
                    o1[0] = x1a[0] * c0[0] - x2a[0] * c0[1]; o2[0] = x1a[0] * c0[1] + x2a[0] * c0[0];
                    o1[1] = x1a[1] * c0[2] - x2a[1] * c0[3]; o2[1] = x1a[1] * c0[3] + x2a[1] * c0[2];
                    o1[2] = x1a[2] * c1[0] - x2a[2] * c1[1]; o2[2] = x1a[2] * c1[1] + x2a[2] * c1[0];
                    o1[3] = x1a[3] * c1[2] - x2a[3] * c1[3]; o2[3] = x1a[3] * c1[3] + x2a[3] * c1[2];
                    o1[4] = x1b[0] * c2[0] - x2b[0] * c2[1]; o2[4] = x1b[0] * c2[1] + x2b[0] * c2[0];
                    o1[5] = x1b[1] * c2[2] - x2b[1] * c2[3]; o2[5] = x1b[1] * c2[3] + x2b[1] * c2[2];
                    o1[6] = x1b[2] * c3[0] - x2b[2] * c3[1]; o2[6] = x1b[2] * c3[1] + x2b[2] * c3[0];
                    o1[7] = x1b[3] * c3[2] - x2b[3] * c3[3]; o2[7] = x1b[3] * c3[3] + x2b[3] * c3[2];
                    u32x4 w1, w2; w1.x = cvt_pk_bf16(o1[0], o1[1]); w1.y = cvt_pk_bf16(o1[2], o1[3]); w1.z = cvt_pk_bf16(o1[4], o1[5]); w1.w = cvt_pk_bf16(o1[6], o1[7]);
                    w2.x = cvt_pk_bf16(o2[0], o2[1]); w2.y = cvt_pk_bf16(o2[2], o2[3]); w2.z = cvt_pk_bf16(o2[4], o2[5]); w2.w = cvt_pk_bf16(o2[6], o2[7]);
                    bf16_t* p = dst + (size_t)r * 512 + head * 128 + i0;
                    *(u32x4*)p = w1; *(u32x4*)(p + 64) = w2; }
        } else {
            const int reg = (pn < 6) ? 1 : (pn < 12 ? 4 : 5); bf16_t* dst = base + (size_t)reg * REG; const int cb = (pn & 1) * 256; const bool act = pn >= 12;
#pragma unroll
            for (int ai = 0; ai < 2; ++ai)
#pragma unroll
                for (int m = 0; m < 4; ++m) { const int r = rbase + ai * HALF + m * 16; const float rs = rstd[r];
#pragma unroll
                    for (int bj = 0; bj < 2; ++bj) { f32x4 v0 = acc[ai][bj][m][0] * rs, v1 = acc[ai][bj][m][1] * rs;
                        if (act) { v0 = (f32x4){silu_f(v0[0]), silu_f(v0[1]), silu_f(v0[2]), silu_f(v0[3])}; v1 = (f32x4){silu_f(v1[0]), silu_f(v1[1]), silu_f(v1[2]), silu_f(v1[3])}; }
                        u32x4 w; w.x = cvt_pk_bf16(v0[0], v0[1]); w.y = cvt_pk_bf16(v0[2], v0[3]); w.z = cvt_pk_bf16(v1[0], v1[1]); w.w = cvt_pk_bf16(v1[2], v1[3]);
                        *(u32x4*)(dst + (size_t)r * 512 + cb + bj * HALF + lc0) = w; } }
        }
    }
};

struct EpiOut {
    static constexpr bool PERM = false, AFTER_DRAIN = false;
    const float* xp; const float* xs; float* out; bf16_t* Hb; float* ssq;
    __device__ __forceinline__ void operator()(const f32x4 (&acc)[2][2][4][2], const Unit& u, int wr, int wc, int fr, int fq) const {
        const int rbase = u.pm * BM + wr * 64 + fr, col0 = u.pn * BM + wc * 32 + 4 * fq;
#pragma unroll
        for (int ai = 0; ai < 2; ++ai)
#pragma unroll
            for (int m = 0; m < 4; ++m) { const int r = rbase + ai * HALF + m * 16;
                const float* xrow = (r < ROWS_P) ? xp + (size_t)r * 1024 : xs + (size_t)(r - ROWS_P) * 1024;
                float s = 0.f;
#pragma unroll
                for (int bj = 0; bj < 2; ++bj)
#pragma unroll
                    for (int n = 0; n < 2; ++n) { const int c = col0 + bj * HALF + n * 16; const f32x4 h = *(const f32x4*)(xrow + c) + acc[ai][bj][m][n];
                        *(f32x4*)(out + (size_t)r * 1024 + c) = h; u32x2 w; w.x = cvt_pk_bf16(h[0], h[1]); w.y = cvt_pk_bf16(h[2], h[3]);
                        *(u32x2*)(Hb + (size_t)r * 1024 + c) = w; s += (h[0] * h[0] + h[1] * h[1]) + (h[2] * h[2] + h[3] * h[3]); }
                s += __shfl_xor(s, 16); s += __shfl_xor(s, 32);
                if (fq == 0) ssq[(size_t)r * 16 + u.pn * 4 + wc] = s; }
    }
};

struct EpiUp {
    static constexpr bool PERM = true, AFTER_DRAIN = false;
    bf16_t* ACT; const float* ssq; float eps;
    __device__ __forceinline__ void operator()(const f32x4 (&acc)[2][2][4][2], const Unit& u, int wr, int wc, int fr, int fq) const {
        const int rbase = u.pm * BM + wr * 64 + fr, col0 = u.pn * BM + wc * 32 + 8 * fq;
#pragma unroll
        for (int ai = 0; ai < 2; ++ai)
#pragma unroll
            for (int m = 0; m < 4; ++m) { const int r = rbase + ai * HALF + m * 16;
                const f32x4 p = *(const f32x4*)(ssq + (size_t)r * 16 + 4 * fq); float s = (p[0] + p[1]) + (p[2] + p[3]);
                s += __shfl_xor(s, 16); s += __shfl_xor(s, 32);
                const float rs = __builtin_amdgcn_rsqf(s * (1.0f / 1024.0f) + eps);
#pragma unroll
                for (int bj = 0; bj < 2; ++bj) { f32x4 v0 = acc[ai][bj][m][0] * rs, v1 = acc[ai][bj][m][1] * rs;
#pragma unroll
                    for (int j = 0; j < 4; ++j) { const float a = fmaxf(v0[j], 0.f), b = fmaxf(v1[j], 0.f); v0[j] = a * a; v1[j] = b * b; }
                    u32x4 w; w.x = cvt_pk_bf16(v0[0], v0[1]); w.y = cvt_pk_bf16(v0[2], v0[3]); w.z = cvt_pk_bf16(v1[0], v1[1]); w.w = cvt_pk_bf16(v1[2], v1[3]);
                    *(u32x4*)(ACT + (size_t)r * 4096 + col0 + bj * HALF) = w; } }
    }
};

struct EpiDown {
    static constexpr bool PERM = false, AFTER_DRAIN = false;
    float* out; float* ssq;
    __device__ __forceinline__ void operator()(const f32x4 (&acc)[2][2][4][2], const Unit& u, int wr, int wc, int fr, int fq) const {
        const int rbase = u.pm * BM + wr * 64 + fr, col0 = u.pn * BM + wc * 32 + 4 * fq;
#pragma unroll
        for (int ai = 0; ai < 2; ++ai)
#pragma unroll
            for (int m = 0; m < 4; ++m) { const int r = rbase + ai * HALF + m * 16; float s = 0.f;
#pragma unroll
                for (int bj = 0; bj < 2; ++bj)
#pragma unroll
                    for (int n = 0; n < 2; ++n) { float* p = out + (size_t)r * 1024 + col0 + bj * HALF + n * 16; const f32x4 h = *(const f32x4*)p + acc[ai][bj][m][n];
                        *(f32x4*)p = h; s += (h[0] * h[0] + h[1] * h[1]) + (h[2] * h[2] + h[3] * h[3]); }
                s += __shfl_xor(s, 16); s += __shfl_xor(s, 32);
                if (fq == 0) ssq[(size_t)r * 16 + u.pn * 4 + wc] = s; }
    }
};
template <class Epi, class Sched, bool ALIGN_EPI = false, bool SP2 = false>
__device__ __forceinline__ void gemm_phase(PG8_LAS unsigned char* lds, const Gemm g, const Sched& S, const Epi& E) {
    const int tid = threadIdx.x, wid = __builtin_amdgcn_readfirstlane(tid >> 6), lane = tid & 63, wr = wid >> 2, wc = wid & 3, fr = lane & 15, fq = lane >> 4;
    const int K = g.K, nt = K / BK;
    unsigned voffA[2], voffB[2];
#pragma unroll
    for (int i = 0; i < 2; ++i) { int R, C; stage_rc(tid * 16 + i * 8192, R, C); const int Rb = Epi::PERM ? ((R & ~31) + perm32(R & 31)) : R;
        voffA[i] = (unsigned)(R * K + C) * 2u; voffB[i] = (unsigned)(Rb * K + C) * 2u; }
    const size_t kstep = (size_t)(BK * 2);
    const size_t hstep = (size_t)HALF * K * 2;
    const size_t tstep = 2 * hstep;
    const unsigned ldsw = (unsigned)wid * 1024u;
    const int aoff = lds_byte(wr * 64 + fr, fq * 8), boff = lds_byte(wc * 32 + fr, fq * 8);
#define PG8_SA(b, h) (((b) * 2 + (h)) * HTB)
#define PG8_SB(b, h) ((4 + (b) * 2 + (h)) * HTB)
#define PG8_STAGE(bufoff, gbase, voff) do { _Pragma("unroll") for (int _i = 0; _i < 2; ++_i) \
        __builtin_amdgcn_global_load_lds((const unsigned*)((const char*)(gbase) + (voff)[_i]), (PG8_LAS unsigned*)(lds + (bufoff) + ldsw + _i * 8192), 16, 0, 0); } while (0)
#define PG8_LDA(dst, b, h) do { _Pragma("unroll") for (int m = 0; m < 4; ++m) _Pragma("unroll") for (int k = 0; k < 2; ++k) dst[m][k] = *(const PG8_LAS bf16x8*)(lds + PG8_SA(b, h) + aoff + m * 2048 + k * 1024); } while (0)
#define PG8_LDB(dst, b, h) do { _Pragma("unroll") for (int n = 0; n < 2; ++n) _Pragma("unroll") for (int k = 0; k < 2; ++k) dst[n][k] = *(const PG8_LAS bf16x8*)(lds + PG8_SB(b, h) + boff + n * 2048 + k * 1024); } while (0)
#define PG8_MMA(ai, bj, At, Bt) do { __builtin_amdgcn_s_setprio(1); _Pragma("unroll") for (int m = 0; m < 4; ++m) _Pragma("unroll") for (int n = 0; n < 2; ++n) _Pragma("unroll") for (int k = 0; k < 2; ++k) \
        acc[ai][bj][m][n] = __builtin_amdgcn_mfma_f32_16x16x32_bf16(Bt[n][k], At[m][k], acc[ai][bj][m][n], 0, 0, 0); __builtin_amdgcn_s_setprio(0); } while (0)
#define PG8_WAIT_V(n) asm volatile("s_waitcnt vmcnt(" #n ")" ::: "memory")
#define PG8_WAIT_L(n) asm volatile("s_waitcnt lgkmcnt(" #n ")" ::: "memory")
#define PG8_BAR __builtin_amdgcn_s_barrier()
#define PG8_SCHED __builtin_amdgcn_sched_barrier(0)
    Unit cur, nxt; int ui = 0;
    if (!S.next(0, cur)) return;
    f32x4 acc[2][2][4][2];
#pragma unroll
    for (int a = 0; a < 2; ++a)
#pragma unroll
        for (int b = 0; b < 2; ++b)
#pragma unroll
            for (int m = 0; m < 4; ++m)
#pragma unroll
                for (int n = 0; n < 2; ++n) acc[a][b][m][n] = (f32x4){0.f, 0.f, 0.f, 0.f};
    bf16x8 At[4][2], B0[2][2], B1[2][2];
    const char* cA = (const char*)g.A + (size_t)cur.pm * tstep; const char* cB = (const char*)g.Bt + (size_t)cur.pn * tstep;
    S.a_ready(cur);
    if constexpr (SP2) {
        PG8_STAGE(PG8_SB(0, 0), cB, voffB); PG8_STAGE(PG8_SB(0, 1), cB + hstep, voffB); PG8_STAGE(PG8_SA(0, 0), cA, voffA); PG8_STAGE(PG8_SA(0, 1), cA + hstep, voffA);
        if (wr == 1) PG8_BAR;
        PG8_WAIT_V(2); PG8_BAR;
        PG8_STAGE(PG8_SB(1, 0), cB + kstep, voffB); PG8_STAGE(PG8_SA(1, 0), cA + kstep, voffA); PG8_STAGE(PG8_SB(1, 1), cB + hstep + kstep, voffB);
        PG8_WAIT_V(6); PG8_BAR;
    } else {
        PG8_STAGE(PG8_SB(0, 0), cB, voffB); PG8_STAGE(PG8_SA(0, 0), cA, voffA); PG8_STAGE(PG8_SB(0, 1), cB + hstep, voffB); PG8_STAGE(PG8_SA(0, 1), cA + hstep, voffA);
        if (wr == 1) PG8_BAR;
        PG8_WAIT_V(4); PG8_BAR;
        PG8_STAGE(PG8_SB(1, 0), cB + kstep, voffB); PG8_STAGE(PG8_SA(1, 0), cA + kstep, voffA); PG8_STAGE(PG8_SB(1, 1), cB + hstep + kstep, voffB);
        PG8_WAIT_V(6); PG8_BAR;
    }
    for (;;) {
        const bool has_next = S.next(ui + 1, nxt);
        const char* nA = has_next ? (const char*)g.A + (size_t)nxt.pm * tstep : cA; const char* nB = has_next ? (const char*)g.Bt + (size_t)nxt.pn * tstep : cB;
        for (int t = 0; t < nt; t += 2) {
            const bool last = (t == nt - 2);
            const char* a1 = cA + (size_t)(t + 1) * kstep;
            const char* a2 = last ? nA : cA + (size_t)(t + 2) * kstep; const char* b2 = last ? nB : cB + (size_t)(t + 2) * kstep;
            const char* a3 = a2 + kstep; const char* b3 = b2 + kstep;
            if (last && has_next) S.a_ready(nxt);
            if constexpr (SP2) {
            PG8_LDB(B0, 0, 0); PG8_LDB(B1, 0, 1); PG8_SCHED; PG8_LDA(At, 0, 0); PG8_STAGE(PG8_SA(1, 1), a1 + hstep, voffA);
            PG8_WAIT_V(8); PG8_WAIT_L(0); PG8_BAR; PG8_MMA(0, 0, At, B0); PG8_MMA(0, 1, At, B1); PG8_BAR; PG8_SCHED;
            PG8_LDA(At, 0, 1); PG8_STAGE(PG8_SB(0, 0), b2, voffB); PG8_STAGE(PG8_SB(0, 1), b2 + hstep, voffB); PG8_STAGE(PG8_SA(0, 0), a2, voffA);
            PG8_WAIT_V(8); PG8_WAIT_L(0); PG8_BAR; PG8_MMA(1, 0, At, B0); PG8_MMA(1, 1, At, B1); PG8_BAR; PG8_SCHED;
            PG8_LDB(B0, 1, 0); PG8_LDB(B1, 1, 1); PG8_SCHED; PG8_LDA(At, 1, 0); PG8_STAGE(PG8_SA(0, 1), a2 + hstep, voffA);
            PG8_WAIT_V(8); PG8_WAIT_L(0); PG8_BAR; PG8_MMA(0, 0, At, B0); PG8_MMA(0, 1, At, B1); PG8_BAR; PG8_SCHED;
            PG8_LDA(At, 1, 1); PG8_STAGE(PG8_SB(1, 0), b3, voffB); PG8_STAGE(PG8_SB(1, 1), b3 + hstep, voffB); PG8_STAGE(PG8_SA(1, 0), a3, voffA);
            PG8_WAIT_V(8); PG8_WAIT_L(0); PG8_BAR; PG8_MMA(1, 0, At, B0); PG8_MMA(1, 1, At, B1); PG8_BAR; PG8_SCHED;
            } else {
            PG8_LDB(B0, 0, 0); PG8_SCHED; PG8_LDA(At, 0, 0); PG8_STAGE(PG8_SA(1, 1), a1 + hstep, voffA);
            PG8_WAIT_L(8); PG8_BAR; PG8_WAIT_L(0); PG8_MMA(0, 0, At, B0); PG8_BAR; PG8_SCHED;
            PG8_LDB(B1, 0, 1); PG8_STAGE(PG8_SB(0, 0), b2, voffB);
            PG8_BAR; PG8_WAIT_L(0); PG8_MMA(0, 1, At, B1); PG8_BAR;
            PG8_LDA(At, 0, 1); PG8_STAGE(PG8_SA(0, 0), a2, voffA);
            PG8_BAR; PG8_WAIT_L(0); PG8_MMA(1, 0, At, B0); PG8_BAR; PG8_SCHED;
            PG8_STAGE(PG8_SB(0, 1), b2 + hstep, voffB);
            PG8_WAIT_V(6); PG8_BAR; PG8_MMA(1, 1, At, B1); PG8_BAR;
            PG8_LDB(B0, 1, 0); PG8_SCHED; PG8_LDA(At, 1, 0); PG8_STAGE(PG8_SA(0, 1), a2 + hstep, voffA);
            PG8_WAIT_L(8); PG8_BAR; PG8_WAIT_L(0); PG8_MMA(0, 0, At, B0); PG8_BAR; PG8_SCHED;
            PG8_LDB(B1, 1, 1); PG8_STAGE(PG8_SB(1, 0), b3, voffB);
            PG8_BAR; PG8_WAIT_L(0); PG8_MMA(0, 1, At, B1); PG8_BAR;
            PG8_LDA(At, 1, 1); PG8_STAGE(PG8_SA(1, 0), a3, voffA);
            PG8_BAR; PG8_WAIT_L(0); PG8_MMA(1, 0, At, B0); PG8_BAR; PG8_SCHED;
            PG8_STAGE(PG8_SB(1, 1), b3 + hstep, voffB);
            PG8_WAIT_V(6); PG8_BAR; PG8_MMA(1, 1, At, B1); PG8_BAR;
            }
        }
        if constexpr (ALIGN_EPI) { if (wr == 0) PG8_BAR; }
        if constexpr (!Epi::AFTER_DRAIN) { E(acc, cur, wr, wc, fr, fq); S.done(cur); }
        if (!has_next) break;
#pragma unroll
        for (int a = 0; a < 2; ++a)
#pragma unroll
            for (int b = 0; b < 2; ++b)
#pragma unroll
                for (int m = 0; m < 4; ++m)
#pragma unroll
                    for (int n = 0; n < 2; ++n) acc[a][b][m][n] = (f32x4){0.f, 0.f, 0.f, 0.f};
        cur = nxt; cA = nA; cB = nB; ++ui;
        if constexpr (ALIGN_EPI) { if (wr == 1) PG8_BAR; }
    }
    PG8_WAIT_V(0);
    if constexpr (!ALIGN_EPI) { if (wr == 0) PG8_BAR; }
    PG8_BAR;
    if constexpr (Epi::AFTER_DRAIN) { E.fused(acc, cur, wr, wc, fr, fq, lds, wid, lane); S.done(cur); }
#undef PG8_SA
#undef PG8_SB
#undef PG8_STAGE
#undef PG8_LDA
#undef PG8_LDB
#undef PG8_MMA
#undef PG8_WAIT_V
#undef PG8_WAIT_L
#undef PG8_BAR
#undef PG8_SCHED
}
}
#ifndef PG8_SP2
#define PG8_SP2 true
#endif
#define GAS __attribute__((address_space(1)))
#define LAS __attribute__((address_space(3)))
typedef unsigned short bf16;
typedef unsigned v4u __attribute__((ext_vector_type(4)));
typedef float f32x4 __attribute__((ext_vector_type(4)));
typedef short bf16x8 __attribute__((ext_vector_type(8)));
typedef GAS unsigned gu32;
typedef GAS unsigned long long gu64;
#define RLX_AGENT __ATOMIC_RELAXED, __HIP_MEMORY_SCOPE_AGENT
#define LDS_WAIT() asm volatile("s_waitcnt lgkmcnt(0)" ::: "memory")
#define VM_WAIT() asm volatile("s_waitcnt vmcnt(0)" ::: "memory")
__device__ __forceinline__ unsigned long long rt() { return __builtin_amdgcn_s_memrealtime(); }
__device__ __forceinline__ unsigned f2bf(float f) { unsigned u = __builtin_bit_cast(unsigned, f); return (u + 0x7fffu + ((u >> 16) & 1u)) >> 16; }
__device__ __forceinline__ unsigned pk2(float lo, float hi) { return f2bf(lo) | (f2bf(hi) << 16); }

#define XB_TMO      128
#define XB_XCNT(j)  (256  + 64 * (j))
#define XB_XSUB(j)  (1280 + 64 * (j))
#define XB_XGEN(j)  (2304 + 64 * (j))
#define XB_TOP      3328
#define XB_TOPGEN   3392
#define XCD_BAR_WORDS 3456
#define XB_SPIN_CAP (1u << 18)

__device__ __forceinline__ unsigned xb_ld(unsigned* p)              { return __hip_atomic_load(p, __ATOMIC_RELAXED, __HIP_MEMORY_SCOPE_AGENT); }
__device__ __forceinline__ unsigned xb_add(unsigned* p, unsigned v) { return __hip_atomic_fetch_add(p, v, __ATOMIC_RELAXED, __HIP_MEMORY_SCOPE_AGENT); }
__device__ __forceinline__ unsigned xb_xcc_id() { return (unsigned)__builtin_amdgcn_s_getreg((3 << 11) | 20) & 0xFu; }
#define XB_SPIN(cond, bar) do { unsigned _sp = 0; while (cond) { __builtin_amdgcn_s_sleep(1); \
    if ((++_sp & 255u) == 0u) { if (xb_ld(&(bar)[XB_TMO])) break; if (_sp > XB_SPIN_CAP) { atomicAdd(&(bar)[XB_TMO], 1u); break; } } } } while (0)

struct XcdBarrier {
    unsigned* bar; unsigned x;
    volatile LAS unsigned* st;
};

__device__ __forceinline__ XcdBarrier xcd_barrier_post(unsigned* bar, volatile LAS unsigned* st) {
    XcdBarrier b; b.bar = bar; b.x = xb_xcc_id(); b.st = st;
    if (threadIdx.x == 0) (void)xb_add(&bar[XB_XCNT(b.x)], 1u);
    return b;
}
__device__ __forceinline__ void xcd_barrier_complete(unsigned* bar, unsigned x, unsigned& nloc, unsigned& nx) {
    const unsigned G = gridDim.x * gridDim.y * gridDim.z;
    unsigned sum, cnt, mine, sp = 0u;
    for (;;) {
        sum = 0u; cnt = 0u; mine = 0u;
#pragma unroll
        for (unsigned j = 0; j < 16; ++j) { const unsigned c = xb_ld(&bar[XB_XCNT(j)]); sum += c; cnt += (c > 0u) ? 1u : 0u; mine = (j == x) ? c : mine; }
        if (sum == G) break;
        __builtin_amdgcn_s_sleep(1);
        if ((++sp & 255u) == 0u) { if (xb_ld(&bar[XB_TMO])) break; if (sp > XB_SPIN_CAP) { atomicAdd(&bar[XB_TMO], 1u); break; } }
    }
    nloc = mine > 0u ? mine : 1u; nx = cnt > 0u ? cnt : 1u;
}

__device__ __forceinline__ void xcd_barrier(const XcdBarrier& b) {
    asm volatile("s_waitcnt vmcnt(0)" ::: "memory");
    __syncthreads();
    if (threadIdx.x == 0) {
        unsigned* bar = b.bar;
        __builtin_amdgcn_s_waitcnt(0);
        unsigned nloc = b.st[0], nx = b.st[1];
        if (nloc == 0u) { xcd_barrier_complete(bar, b.x, nloc, nx); b.st[0] = nloc; b.st[1] = nx; }
        const unsigned old = xb_add(&bar[XB_XSUB(b.x)], 1u);
        const unsigned gen = old / nloc;
        if (old + 1u == (gen + 1u) * nloc) {
            __builtin_amdgcn_fence(__ATOMIC_RELEASE, "agent");
            asm volatile("s_waitcnt vmcnt(0)" ::: "memory");
            const unsigned og = xb_add(&bar[XB_TOP], 1u);
            const unsigned tg = og / nx;
            if (og + 1u == (tg + 1u) * nx) xb_add(&bar[XB_TOPGEN], 1u);
            else XB_SPIN(xb_ld(&bar[XB_TOPGEN]) == tg, bar);
            __builtin_amdgcn_fence(__ATOMIC_ACQUIRE, "agent");
            xb_add(&bar[XB_XGEN(b.x)], 1u);
            asm volatile("s_waitcnt vmcnt(0)" ::: "memory");
        } else {
            XB_SPIN(xb_ld(&bar[XB_XGEN(b.x)]) == gen, bar);
            __builtin_amdgcn_fence(__ATOMIC_ACQUIRE, "agent");
            asm volatile("s_waitcnt vmcnt(0)" ::: "memory");
        }
    }
    __syncthreads();
}


constexpr int NWAVES = 8;
constexpr int DM = 1024, NBP = 4, SEQ = 8192, NBS = 32, DSEQ = 64, NMETA = 16;
constexpr int DCONV = 512, NH = 4, DH = 128, DRET = 512, DFF = 4096, DIN = 3584;
constexpr int MP = NBP * SEQ, MS = NBS * DSEQ, M = MP + MS;
constexpr float NORM_EPS = 1e-6f, GN_EPS = 1e-5f;
static_assert(MP == pg8::ROWS_P && M % 256 == 0, "row geometry");
constexpr size_t O_Y = 0, O_CONVP = (size_t)M * DM, O_RETP = O_CONVP + NBP * 2 * DCONV, O_CONVS = O_RETP + (size_t)NBP * NH * DH * DH, O_RETS = O_CONVS + NBS * 2 * DCONV,
                 O_END = O_RETS + (size_t)NBS * NH * DH * DH;
constexpr size_t MiB = 1u << 20;
constexpr size_t WS_CTL = 0, CTL_ZERO_BYTES = 1 * MiB;
constexpr size_t WS_RSTD1 = 1 * MiB, WS_SSQ1 = 2 * MiB, WS_SSQ2 = 5 * MiB, WS_ROPE = 8 * MiB, WS_META = 12 * MiB;
constexpr size_t WS_WIN = 16 * MiB, WS_WOUT = 24 * MiB, WS_WUP = 26 * MiB, WS_WDN = 34 * MiB;
constexpr size_t WS_XB = 48 * MiB;
constexpr size_t WS_U = 116 * MiB, WS_BG = 150 * MiB, WS_Q = 184 * MiB, WS_K = 218 * MiB, WS_V = 252 * MiB, WS_SG = 286 * MiB;
constexpr size_t WS_MIX = 320 * MiB;
constexpr size_t WS_ACT = 116 * MiB;
constexpr size_t WS_TG = 388 * MiB;
constexpr size_t WS_END = 420 * MiB;
static_assert(WS_BG - WS_U == (size_t)M * 512 * 2 && WS_Q - WS_BG == WS_BG - WS_U && WS_K - WS_Q == WS_BG - WS_U && WS_V - WS_K == WS_BG - WS_U && WS_SG - WS_V == WS_BG - WS_U, "six bf16 regions back to back");
static_assert(WS_XB + (size_t)M * DM * 2 <= WS_U && WS_SG + (size_t)M * 512 * 2 <= WS_MIX && WS_MIX + (size_t)M * DM * 2 <= WS_TG && WS_ACT + (size_t)M * DFF * 2 <= WS_TG, "ws map");
static_assert(WS_SSQ1 + (size_t)M * 16 * 4 <= WS_SSQ2 && WS_SSQ2 + (size_t)M * 16 * 4 <= WS_ROPE && WS_ROPE + (size_t)8192 * 64 * 8 <= WS_META, "ws map small");
constexpr int CW_TMO = 0, CW_BAR = 4096;
constexpr int RING_OFF = 0, RING_BYTES = 131072, LDSCTL_OFF = RING_BYTES, MISC_OFF = LDSCTL_OFF + 320, LDS_BYTES = 147456;

struct Frame {
    LAS unsigned char* lds;
    volatile LAS unsigned* MISC;
    gu32* ctl;
    int tid, lane, wave, vcu, G;
    const float* in[14];
    float* out;
    unsigned char* ws;
};
__device__ __forceinline__ float wave_sum(float v) {
#pragma unroll
    for (int o = 1; o < 64; o <<= 1) v += __shfl_xor(v, o);
    return v;
}
__device__ __forceinline__ float bf2f(unsigned short b) { return __builtin_bit_cast(float, (unsigned)b << 16); }

__device__ __forceinline__ int win_src_col(int n0, float& sc) {
    const int pn = n0 >> 8, lc = n0 & 255; sc = 1.0f;
    if (pn < 4) return (lc < 128) ? (128 * pn + lc) : (1024 + 128 * pn + (lc - 128));
    if (pn < 6) return 512 + 256 * (pn - 4) + lc;
    if (pn < 10) { const int isk = (pn >= 8) ? 1 : 0, hp = (pn - 6) & 1, half = lc >> 7, l2 = lc & 127, head = 2 * hp + (l2 >> 6), i = l2 & 63; if (isk) sc = 0.08838834764831845f;
        return 1536 + 512 * isk + 128 * head + 64 * half + i; }
    if (pn < 12) return 2560 + 256 * (pn - 10) + lc;
    return 3072 + 256 * (pn - 12) + lc;
}
__device__ __forceinline__ void p0_transpose_item(const float* W, int K, int N, bf16* WT, int k0, int n0, int src0, const float* ks, float cs, LAS float* scr, int lane) {
#pragma unroll 8
    for (int i = 0; i < 32; ++i) { const int kk = 2 * i + (lane >> 5); const float s = ks ? ks[k0 + kk] * cs : cs; scr[kk * 33 + (lane & 31)] = W[(size_t)(k0 + kk) * N + src0 + (lane & 31)] * s; }
    LDS_WAIT(); asm volatile("" ::: "memory");
    const int c = lane & 7;
#pragma unroll
    for (int j = 0; j < 4; ++j) { const int n = (lane >> 3) + 8 * j; const LAS float* s = scr + (8 * c) * 33 + n;
        v4u o; o.x = pk2(s[0 * 33], s[1 * 33]); o.y = pk2(s[2 * 33], s[3 * 33]); o.z = pk2(s[4 * 33], s[5 * 33]); o.w = pk2(s[6 * 33], s[7 * 33]);
        *(GAS v4u*)(WT + (size_t)(n0 + n) * K + k0 + 8 * c) = o; }
    LDS_WAIT(); asm volatile("" ::: "memory");
}
__device__ __forceinline__ void x_row_to_bf16(int lane, const float* xrow, bf16* orow, float* rstd_out) {
    const GAS f32x4* xr = (const GAS f32x4*)xrow + lane;
    f32x4 v[4]; float s = 0.f;
#pragma unroll
    for (int j = 0; j < 4; ++j) { v[j] = xr[64 * j]; s += (v[j].x * v[j].x + v[j].y * v[j].y) + (v[j].z * v[j].z + v[j].w * v[j].w); }
    s = wave_sum(s);
    GAS unsigned long long* o8 = (GAS unsigned long long*)orow + lane;
#pragma unroll
    for (int j = 0; j < 4; ++j) o8[64 * j] = (unsigned long long)pk2(v[j].x, v[j].y) | ((unsigned long long)pk2(v[j].z, v[j].w) << 32);
    if (lane == 0) *rstd_out = 1.0f / sqrtf(s * (1.0f / DM) + NORM_EPS);
}
__device__ __forceinline__ void p0_prologue(Frame& F) {
    LAS float* scr = (LAS float*)(F.lds + RING_OFF + F.wave * 16384);
    const int gw = F.vcu * NWAVES + F.wave, NGW = F.G * NWAVES;
    const float* w_in = F.in[6]; const float* w_out = F.in[9]; const float* w_up = F.in[11]; const float* w_dn = F.in[12];
    bf16* WIN = (bf16*)(F.ws + WS_WIN); bf16* WOUT = (bf16*)(F.ws + WS_WOUT); bf16* WUP = (bf16*)(F.ws + WS_WUP); bf16* WDN = (bf16*)(F.ws + WS_WDN);
    constexpr int I_IN = (DM / 64) * (DIN / 32), I_OUT = (DM / 64) * (DM / 32), I_UP = (DM / 64) * (DFF / 32), I_DN = (DFF / 64) * (DM / 32);
    constexpr int NITEMS = I_IN + I_OUT + I_UP + I_DN;
    for (int it = gw; it < NITEMS; it += NGW) {
        int r = it;
        if (r < I_IN) { const int nblk = DIN / 32, kb = r / nblk, nb = r % nblk; float cs; const int src0 = win_src_col(32 * nb, cs);
            p0_transpose_item(w_in, DM, DIN, WIN, 64 * kb, 32 * nb, src0, F.in[5], cs, scr, F.lane); continue; } r -= I_IN;
        if (r < I_OUT) { const int nblk = DM / 32, kb = r / nblk, nb = r % nblk; p0_transpose_item(w_out, DM, DM, WOUT, 64 * kb, 32 * nb, 32 * nb, nullptr, 1.0f, scr, F.lane); continue; } r -= I_OUT;
        if (r < I_UP) { const int nblk = DFF / 32, kb = r / nblk, nb = r % nblk; p0_transpose_item(w_up, DM, DFF, WUP, 64 * kb, 32 * nb, 32 * nb, F.in[10], 1.0f, scr, F.lane); continue; } r -= I_UP;
        { const int nblk = DM / 32, kb = r / nblk, nb = r % nblk; p0_transpose_item(w_dn, DFF, DM, WDN, 64 * kb, 32 * nb, 32 * nb, nullptr, 1.0f, scr, F.lane); }
    }
    bf16* XB = (bf16*)(F.ws + WS_XB); float* RS = (float*)(F.ws + WS_RSTD1);
    for (int m = gw; m < M; m += NGW) { const float* xrow = (m < MP) ? F.in[0] + (size_t)m * DM : F.in[1] + (size_t)(m - MP) * DM; x_row_to_bf16(F.lane, xrow, XB + (size_t)m * DM, RS + m); }
    float* ROPE = (float*)(F.ws + WS_ROPE);
    for (int e = (F.vcu * NWAVES * 64) + F.tid; e < 8192 * 64; e += F.G * NWAVES * 64) { const int pos = e >> 6, i = e & 63;
        const float invf = (float)exp2(-(double)i * (13.287712379549449 / 64.0));
        const double rev = (double)((float)pos * invf) * 0.15915494309189535;
        const float fr = (float)(rev - __builtin_rint(rev));
        ROPE[2 * e] = __builtin_amdgcn_cosf(fr); ROPE[2 * e + 1] = __builtin_amdgcn_sinf(fr); }
}

__device__ __forceinline__ void meta_proj(Frame& F) {
    LAS float* hm = (LAS float*)(F.lds + RING_OFF);
    const float* meta = F.in[4];
    for (int rr = 0; rr < 2; ++rr) { const int row = F.wave * 2 + rr; const GAS f32x4* xr = (const GAS f32x4*)(meta + (size_t)row * DM) + F.lane;
        f32x4 v[4]; float s = 0.f;
#pragma unroll
        for (int j = 0; j < 4; ++j) { v[j] = xr[64 * j]; s += (v[j].x * v[j].x + v[j].y * v[j].y) + (v[j].z * v[j].z + v[j].w * v[j].w); }
        const float rs = 1.0f / sqrtf(wave_sum(s) * (1.0f / DM) + NORM_EPS);
#pragma unroll
        for (int j = 0; j < 4; ++j) *(LAS f32x4*)(hm + row * DM + 4 * (F.lane + 64 * j)) = v[j] * rs; }
    LDS_WAIT(); __syncthreads();
    const bf16* WIN = (const bf16*)(F.ws + WS_WIN); float* MPJ = (float*)(F.ws + WS_META);
    const int gw = F.vcu * NWAVES + F.wave, NGW = F.G * NWAVES;
    for (int n = gw; n < DIN; n += NGW) {
        const GAS v4u* wp = (const GAS v4u*)(WIN + (size_t)n * DM + 16 * F.lane); const v4u w0 = wp[0], w1 = wp[1];
        float wv[16];
        wv[0] = bf2f(w0.x & 0xffff); wv[1] = bf2f(w0.x >> 16); wv[2] = bf2f(w0.y & 0xffff); wv[3] = bf2f(w0.y >> 16); wv[4] = bf2f(w0.z & 0xffff); wv[5] = bf2f(w0.z >> 16); wv[6] = bf2f(w0.w & 0xffff); wv[7] = bf2f(w0.w >> 16);
        wv[8] = bf2f(w1.x & 0xffff); wv[9] = bf2f(w1.x >> 16); wv[10] = bf2f(w1.y & 0xffff); wv[11] = bf2f(w1.y >> 16); wv[12] = bf2f(w1.z & 0xffff); wv[13] = bf2f(w1.z >> 16); wv[14] = bf2f(w1.w & 0xffff); wv[15] = bf2f(w1.w >> 16);
        float res = 0.f;
#pragma unroll 2
        for (int row = 0; row < 16; ++row) { const LAS f32x4* h = (const LAS f32x4*)(hm + row * DM + 16 * F.lane); float a = 0.f;
#pragma unroll
            for (int q = 0; q < 4; ++q) { const f32x4 hv = h[q]; a += hv.x * wv[4 * q] + hv.y * wv[4 * q + 1] + hv.z * wv[4 * q + 2] + hv.w * wv[4 * q + 3]; }
            a = wave_sum(a); if (F.lane == row) res = a; }
        if (F.lane < 16) MPJ[(size_t)F.lane * DIN + n] = res;
    }
}
__device__ __forceinline__ int mcol_xt(int c) { return 256 * (c >> 7) + (c & 127); }
__device__ __forceinline__ int mcol_cg(int c) { return 256 * (c >> 7) + 128 + (c & 127); }
__device__ __forceinline__ int mcol_k(int head, int d) { return 256 * (8 + (head >> 1)) + 128 * (d >> 6) + 64 * (head & 1) + (d & 63); }
__device__ __forceinline__ int mcol_v(int head, int e) { return 2560 + 128 * head + e; }

__device__ __forceinline__ void conv_phase(Frame& F) {
    const bf16* U = (const bf16*)(F.ws + WS_U); const bf16* BG = (const bf16*)(F.ws + WS_BG); bf16* MIX = (bf16*)(F.ws + WS_MIX);
    const float* MPJ = (const float*)(F.ws + WS_META); const float* cw = F.in[7]; const float* sconv = F.in[2];
    const int nthr = F.G * NWAVES * 64;
    for (int item = F.vcu * NWAVES * 64 + F.tid; item < M * 64; item += nthr) {
        const int r = item >> 6, c8 = (item & 63) * 8; const bool pr = r < MP; const int t = pr ? (r & 8191) : (r & 63), T = pr ? SEQ : DSEQ;
        float u0[8], u1[8], u2[8], bg[8];
        { const v4u a = *(const GAS v4u*)(U + (size_t)r * 512 + c8); u0[0] = bf2f(a.x & 0xffff); u0[1] = bf2f(a.x >> 16); u0[2] = bf2f(a.y & 0xffff); u0[3] = bf2f(a.y >> 16); u0[4] = bf2f(a.z & 0xffff); u0[5] = bf2f(a.z >> 16); u0[6] = bf2f(a.w & 0xffff); u0[7] = bf2f(a.w >> 16); }
        { const v4u a = *(const GAS v4u*)(BG + (size_t)r * 512 + c8); bg[0] = bf2f(a.x & 0xffff); bg[1] = bf2f(a.x >> 16); bg[2] = bf2f(a.y & 0xffff); bg[3] = bf2f(a.y >> 16); bg[4] = bf2f(a.z & 0xffff); bg[5] = bf2f(a.z >> 16); bg[6] = bf2f(a.w & 0xffff); bg[7] = bf2f(a.w >> 16); }
        if (t >= 1) { const v4u a = *(const GAS v4u*)(U + (size_t)(r - 1) * 512 + c8); u1[0] = bf2f(a.x & 0xffff); u1[1] = bf2f(a.x >> 16); u1[2] = bf2f(a.y & 0xffff); u1[3] = bf2f(a.y >> 16); u1[4] = bf2f(a.z & 0xffff); u1[5] = bf2f(a.z >> 16); u1[6] = bf2f(a.w & 0xffff); u1[7] = bf2f(a.w >> 16); }
        if (t >= 2) { const v4u a = *(const GAS v4u*)(U + (size_t)(r - 2) * 512 + c8); u2[0] = bf2f(a.x & 0xffff); u2[1] = bf2f(a.x >> 16); u2[2] = bf2f(a.y & 0xffff); u2[3] = bf2f(a.y >> 16); u2[4] = bf2f(a.z & 0xffff); u2[5] = bf2f(a.z >> 16); u2[6] = bf2f(a.w & 0xffff); u2[7] = bf2f(a.w >> 16); }
        if (t < 2) {
#pragma unroll
            for (int j = 0; j < 8; ++j) { const int c = c8 + j; float h0, h1;
                if (pr) { h0 = MPJ[(size_t)14 * DIN + mcol_xt(c)] * MPJ[(size_t)14 * DIN + mcol_cg(c)]; h1 = MPJ[(size_t)15 * DIN + mcol_xt(c)] * MPJ[(size_t)15 * DIN + mcol_cg(c)]; }
                else { const int s = (r - MP) >> 6; h0 = sconv[((size_t)s * 2 + 0) * DCONV + c]; h1 = sconv[((size_t)s * 2 + 1) * DCONV + c]; }
                if (t == 0) { u1[j] = h1; u2[j] = h0; } else { u2[j] = h1; } }
        }
        float o[8];
#pragma unroll
        for (int j = 0; j < 8; ++j) { const int c = c8 + j; o[j] = bg[j] * (cw[c] * u2[j] + cw[DCONV + c] * u1[j] + cw[2 * DCONV + c] * u0[j]); }
        v4u w; w.x = pk2(o[0], o[1]); w.y = pk2(o[2], o[3]); w.z = pk2(o[4], o[5]); w.w = pk2(o[6], o[7]);
        *(GAS v4u*)(MIX + (size_t)r * DM + c8) = w;
        if (t >= T - 2) { float* dst = pr ? F.out + O_CONVP + ((size_t)(r >> 13) * 2 + (t - (T - 2))) * DCONV + c8 : F.out + O_CONVS + ((size_t)((r - MP) >> 6) * 2 + (t - (T - 2))) * DCONV + c8;
            *(f32x4*)dst = (f32x4){u0[0], u0[1], u0[2], u0[3]}; *(f32x4*)(dst + 4) = (f32x4){u0[4], u0[5], u0[6], u0[7]}; }
    }
}

__device__ __forceinline__ void ret_oracle_task(Frame& F, int stream, int head, bf16* MIXO, float* retp, float* rets) {
    LAS float* S = (LAS float*)(F.lds);
    LAS bf16* qs = (LAS bf16*)(F.lds + 65536); LAS bf16* ks = (LAS bf16*)(F.lds + 81920); LAS bf16* vs = (LAS bf16*)(F.lds + 98304);
    LAS float* sc = (LAS float*)(F.lds + 114688);
    const bf16* Q = (const bf16*)(F.ws + WS_Q); const bf16* Kb = (const bf16*)(F.ws + WS_K); const bf16* V = (const bf16*)(F.ws + WS_V); const bf16* SG = (const bf16*)(F.ws + WS_SG);
    const float* MPJ = (const float*)(F.ws + WS_META); const float* ROPE = (const float*)(F.ws + WS_ROPE); const float* gnw = F.in[8];
    const float lg = logf(1.0f - exp2f(-5.0f - (float)head));
    const bool pr = stream < NBP; const int tid = F.tid;
    __syncthreads();
    if (pr) {
        LAS float* km = sc; LAS float* vm = sc + 2048;
        for (int idx = tid; idx < 2048; idx += 512) { const int j = idx >> 7, d = idx & 127, i = d & 63, ap = 16 - j;
            const float x1 = MPJ[(size_t)j * DIN + mcol_k(head, i)], x2 = MPJ[(size_t)j * DIN + mcol_k(head, 64 + i)];
            const float c = ROPE[2 * (ap * 64 + i)], s = -ROPE[2 * (ap * 64 + i) + 1];
            km[idx] = (d < 64) ? (x1 * c - x2 * s) : (x1 * s + x2 * c);
            vm[idx] = MPJ[(size_t)j * DIN + mcol_v(head, d)]; }
        LDS_WAIT(); __syncthreads();
        for (int idx = tid; idx < 16384; idx += 512) { const int d = idx >> 7, e = idx & 127; float a = 0.f;
            for (int j = 0; j < 16; ++j) a += km[j * 128 + d] * __expf(lg * (float)(15 - j)) * vm[j * 128 + e];
            S[idx] = a; }
    } else {
        const float* sr = F.in[3] + ((size_t)(stream - NBP) * NH + head) * DH * DH;
        for (int idx = tid; idx < 16384; idx += 512) S[idx] = sr[idx];
    }
    LDS_WAIT(); __syncthreads();
    const int nchunk = pr ? SEQ / 64 : 1;
    for (int ch = 0; ch < nchunk; ++ch) {
        const int row0 = pr ? stream * SEQ + ch * 64 : MP + (stream - NBP) * 64;
        for (int x = tid; x < 1024; x += 512) { const int i = x >> 4, c8 = (x & 15) * 8; const size_t g = (size_t)(row0 + i) * 512 + head * 128 + c8;
            *(LAS v4u*)(qs + i * 128 + c8) = *(const GAS v4u*)(Q + g); *(LAS v4u*)(ks + i * 128 + c8) = *(const GAS v4u*)(Kb + g); *(LAS v4u*)(vs + i * 128 + c8) = *(const GAS v4u*)(V + g); }
        LDS_WAIT(); __syncthreads();
        { const int i = tid >> 3, jg = tid & 7;
            for (int jj = 0; jj < 8; ++jj) { const int j = 8 * jg + jj; float a = 0.f;
                if (j <= i) { for (int d = 0; d < 128; ++d) a += bf2f(qs[i * 128 + d]) * bf2f(ks[j * 128 + d]); a *= __expf(lg * (float)(i - j)); }
                sc[i * 64 + j] = a; } }
        LDS_WAIT(); __syncthreads();
        { const int i = tid >> 3, eg = tid & 7, e0 = 16 * eg; float acc[16];
#pragma unroll
            for (int e = 0; e < 16; ++e) acc[e] = 0.f;
            for (int j = 0; j <= i; ++j) { const float s = sc[i * 64 + j];
#pragma unroll
                for (int e = 0; e < 16; ++e) acc[e] += s * bf2f(vs[j * 128 + e0 + e]); }
            const float cd = __expf(lg * (float)(i + 1));
            for (int d = 0; d < 128; ++d) { const float qd = bf2f(qs[i * 128 + d]) * cd;
#pragma unroll
                for (int e = 0; e < 16; ++e) acc[e] += qd * S[d * 128 + e0 + e]; }
            float sum = 0.f;
#pragma unroll
            for (int e = 0; e < 16; ++e) sum += acc[e];
            sum += __shfl_xor(sum, 1); sum += __shfl_xor(sum, 2); sum += __shfl_xor(sum, 4);
            const float mu = sum * (1.0f / 128.0f); float var = 0.f;
#pragma unroll
            for (int e = 0; e < 16; ++e) { const float dd = acc[e] - mu; var += dd * dd; }
            var += __shfl_xor(var, 1); var += __shfl_xor(var, 2); var += __shfl_xor(var, 4);
            const float rsd = 1.0f / sqrtf(var * (1.0f / 128.0f) + GN_EPS);
            const size_t r = (size_t)(row0 + i);
#pragma unroll
            for (int e = 0; e < 16; e += 2) { const int cc = head * 128 + e0 + e;
                const float o0 = (acc[e] - mu) * rsd * gnw[cc] * bf2f(SG[r * 512 + cc]), o1 = (acc[e + 1] - mu) * rsd * gnw[cc + 1] * bf2f(SG[r * 512 + cc + 1]);
                *(GAS unsigned*)(MIXO + r * DM + 512 + cc) = pk2(o0, o1); } }
        __syncthreads();
        { const int d = tid >> 2, e0 = 32 * (tid & 3); float acc[32]; const float g64 = __expf(lg * 64.0f);
#pragma unroll
            for (int e = 0; e < 32; ++e) acc[e] = g64 * S[d * 128 + e0 + e];
            for (int j = 0; j < 64; ++j) { const float kd = bf2f(ks[j * 128 + d]) * __expf(lg * (float)(63 - j));
#pragma unroll
                for (int e = 0; e < 32; ++e) acc[e] += kd * bf2f(vs[j * 128 + e0 + e]); }
#pragma unroll
            for (int e = 0; e < 32; ++e) S[d * 128 + e0 + e] = acc[e]; }
        LDS_WAIT(); __syncthreads();
    }
    float* dst = pr ? retp + ((size_t)stream * NH + head) * DH * DH : rets + ((size_t)(stream - NBP) * NH + head) * DH * DH;
    for (int idx = tid; idx < 16384; idx += 512) dst[idx] = S[idx];
    __syncthreads();
}

__device__ __forceinline__ void final_norm(Frame& F) {
    const float* ssq = (const float*)(F.ws + WS_SSQ2); const float* wf = F.in[13];
    const int gw = F.vcu * NWAVES + F.wave, NGW = F.G * NWAVES;
    f32x4 wv[4];
#pragma unroll
    for (int j = 0; j < 4; ++j) wv[j] = *(const f32x4*)(wf + 4 * (F.lane + 64 * j));
    for (int m = gw; m < M; m += NGW) {
        float s = (F.lane < 16) ? ssq[(size_t)m * 16 + F.lane] : 0.f; s = wave_sum(s);
        const float rs = 1.0f / sqrtf(s * (1.0f / DM) + NORM_EPS);
        GAS f32x4* p = (GAS f32x4*)(F.out + (size_t)m * DM) + F.lane;
#pragma unroll
        for (int j = 0; j < 4; ++j) { const f32x4 v = p[64 * j]; p[64 * j] = v * rs * wv[j]; }
    }
}

constexpr int N_PHASES = 7;
struct Args { const float* in[14]; float* out; unsigned char* ws; int ph_lo, ph_hi; };
static_assert(sizeof(Args) == 14 * 8 + 8 + 8 + 8, "Args has no padding");
__global__ void __launch_bounds__(NWAVES * 64, 2) mk_fwd(Args args) {
    extern __shared__ __attribute__((aligned(16))) unsigned char lds[];
    Frame F;
    F.lds = (LAS unsigned char*)lds;
    F.MISC = (volatile LAS unsigned*)(F.lds + MISC_OFF);
    F.tid = threadIdx.x; F.lane = F.tid & 63; F.wave = __builtin_amdgcn_readfirstlane(F.tid >> 6);
    F.G = gridDim.x; { const int bx = blockIdx.x; F.vcu = (F.G % 8 == 0) ? (bx % 8) * (F.G / 8) + bx / 8 : bx; }
    F.ws = args.ws; F.out = args.out; F.ctl = (gu32*)(args.ws + WS_CTL);
#pragma unroll
    for (int i = 0; i < 14; ++i) F.in[i] = args.in[i];
    for (int u = F.tid; u < (LDS_BYTES - LDSCTL_OFF) / 4; u += NWAVES * 64) ((LAS unsigned*)(F.lds + LDSCTL_OFF))[u] = 0u;
    __syncthreads();
    const int lo = args.ph_lo, hi = args.ph_hi;
    const bool one_launch = (lo == 0 && hi == N_PHASES);
    XcdBarrier bar; bar.bar = (unsigned*)(F.ctl + CW_BAR); bar.x = 0; bar.st = nullptr;
    if (one_launch) bar = xcd_barrier_post((unsigned*)(F.ctl + CW_BAR), F.MISC + 8);
#define IN(k) (lo <= (k) && (k) < hi)
#define SEAM(k) do { if (IN(k) && IN((k) + 1)) xcd_barrier(bar); } while (0)

    if (IN(0)) { p0_prologue(F); } SEAM(0);
    if (IN(1)) {
        pg8::Gemm g{(const pg8::bf16_t*)(F.ws + WS_XB), (const pg8::bf16_t*)(F.ws + WS_WIN), M, DIN, DM}; pg8::StaticOrder S; S.init(M, DIN, F.G, (int)blockIdx.x);
        pg8::EpiIn E{(pg8::bf16_t*)(F.ws + WS_U), (const float*)(F.ws + WS_RSTD1), (const float*)(F.ws + WS_ROPE)};
        pg8::gemm_phase<pg8::EpiIn, pg8::StaticOrder, true, true>(F.lds + RING_OFF, g, S, E);
        meta_proj(F);
    } SEAM(1);
    if (IN(2)) {
        conv_phase(F);
        for (int task = blockIdx.x; task < (NBP + NBS) * NH; task += F.G) ret_oracle_task(F, task >> 2, task & 3, (bf16*)(F.ws + WS_MIX), F.out + O_RETP, F.out + O_RETS);
    } SEAM(2);
    if (IN(3)) {
        pg8::Gemm g{(const pg8::bf16_t*)(F.ws + WS_MIX), (const pg8::bf16_t*)(F.ws + WS_WOUT), M, DM, DM}; pg8::StaticOrder S; S.init(M, DM, F.G, (int)blockIdx.x);
        pg8::EpiOut E{F.in[0], F.in[1], F.out + O_Y, (pg8::bf16_t*)(F.ws + WS_XB), (float*)(F.ws + WS_SSQ1)};
        pg8::gemm_phase<pg8::EpiOut, pg8::StaticOrder, true, true>(F.lds + RING_OFF, g, S, E);
    } SEAM(3);
    if (IN(4)) {
        pg8::Gemm g{(const pg8::bf16_t*)(F.ws + WS_XB), (const pg8::bf16_t*)(F.ws + WS_WUP), M, DFF, DM}; pg8::StaticOrder S; S.init(M, DFF, F.G, (int)blockIdx.x);
        pg8::EpiUp E{(pg8::bf16_t*)(F.ws + WS_ACT), (const float*)(F.ws + WS_SSQ1), NORM_EPS};
        pg8::gemm_phase<pg8::EpiUp, pg8::StaticOrder, true, true>(F.lds + RING_OFF, g, S, E);
    } SEAM(4);
    if (IN(5)) {
        pg8::Gemm g{(const pg8::bf16_t*)(F.ws + WS_ACT), (const pg8::bf16_t*)(F.ws + WS_WDN), M, DM, DFF}; pg8::StaticOrder S; S.init(M, DM, F.G, (int)blockIdx.x);
        pg8::EpiDown E{F.out + O_Y, (float*)(F.ws + WS_SSQ2)};
        pg8::gemm_phase<pg8::EpiDown, pg8::StaticOrder, true, true>(F.lds + RING_OFF, g, S, E);
    } SEAM(5);
    if (IN(6)) { final_norm(F); }
#undef IN
#undef SEAM
}

#ifndef MK_ONE_LAUNCH
#define MK_ONE_LAUNCH 1
#endif
extern "C" void kernel_launch(void* const* d_in, const int* in_sizes, int n_in, void* d_out, int out_size, void* d_ws, size_t ws_size, hipStream_t stream) {
    static int grid = 0;
    if (grid == 0) {
        if (n_in != 14 || in_sizes[0] != MP * DM || in_sizes[1] != MS * DM || (size_t)out_size != O_END || ws_size < WS_END) {
            fprintf(stderr, "kernel_launch: unexpected shapes: n_in %d in0 %d in1 %d out %d ws %zu (need %zu); nothing launched\n", n_in, n_in > 0 ? in_sizes[0] : -1, n_in > 1 ? in_sizes[1] : -1, out_size, ws_size, (size_t)WS_END); grid = -1; return; }
        int dev = 0, cus = 0;
        if (hipGetDevice(&dev) != hipSuccess || hipDeviceGetAttribute(&cus, hipDeviceAttributeMultiprocessorCount, dev) != hipSuccess) { fprintf(stderr, "kernel_launch: device query failed\n"); grid = -1; return; }
        if (hipFuncSetAttribute((const void*)mk_fwd, hipFuncAttributeMaxDynamicSharedMemorySize, LDS_BYTES) != hipSuccess) { fprintf(stderr, "kernel_launch: hipFuncSetAttribute failed\n"); grid = -1; return; }
        int per_cu = 0;
        if (hipOccupancyMaxActiveBlocksPerMultiprocessor(&per_cu, (const void*)mk_fwd, NWAVES * 64, LDS_BYTES) != hipSuccess || per_cu < 1) fprintf(stderr, "kernel_launch: occupancy query says %d per CU\n", per_cu);
        (void)hipGetLastError();
        grid = cus;
    }
    if (grid < 0) return;
    if (hipMemsetAsync((char*)d_ws + WS_CTL, 0, CTL_ZERO_BYTES, stream) != hipSuccess) { fprintf(stderr, "kernel_launch: memset failed\n"); return; }
    Args a{};
    for (int i = 0; i < 14; ++i) a.in[i] = (const float*)d_in[i];
    a.out = (float*)d_out; a.ws = (unsigned char*)d_ws;
#if MK_ONE_LAUNCH
    a.ph_lo = 0; a.ph_hi = N_PHASES;
    hipLaunchKernelGGL(mk_fwd, dim3(grid), dim3(NWAVES * 64), LDS_BYTES, stream, a);
#else
    for (int p = 0; p < N_PHASES; ++p) { a.ph_lo = p; a.ph_hi = p + 1; hipLaunchKernelGGL(mk_fwd, dim3(grid), dim3(NWAVES * 64), LDS_BYTES, stream, a); }
#endif
    const hipError_t le = hipPeekAtLastError();
    if (le != hipSuccess) fprintf(stderr, "kernel_launch: launch failed: %s\n", hipGetErrorName(le));
}
```

```cpp
#include <hip/hip_runtime.h>
#include <cstdio>
#include <cstdint>
#ifndef RET_ORACLE
#define RET_ORACLE 0
#endif
namespace pg8 {
#define PG8_LAS __attribute__((address_space(3)))
typedef unsigned short bf16_t;
typedef short bf16x8 __attribute__((ext_vector_type(8)));
typedef float f32x4 __attribute__((ext_vector_type(4)));
typedef unsigned u32x4 __attribute__((ext_vector_type(4)));
constexpr int BM = 256, BK = 64, HALF = 128, HTB = HALF * BK * 2  , STAGE_BYTES = 8 * HTB, NXCD = 8, WGM = 8;

__host__ __device__ __forceinline__ int lds_byte(int r, int c) { const int st = (r >> 4) * 2 + (c >> 5), rr = r & 15, cc = c & 31, ob = rr * 64 + cc * 2; return st * 1024 + (ob ^ (((ob >> 9) & 1) << 5)); }
__host__ __device__ __forceinline__ void stage_rc(int b, int& R, int& C) { const int st = b / 1024, sb = b % 1024, swz = sb ^ (((sb >> 9) & 1) << 5); R = (st >> 1) * 16 + swz / 64; C = (st & 1) * 32 + (swz % 64) / 2; }
__host__ __device__ __forceinline__ int perm32(int rho) { const int n = rho >> 4, i = rho & 15; return 8 * (i >> 2) + 4 * n + (i & 3); }

struct Unit { int pm, pn; };
struct Gemm { const bf16_t* A; const bf16_t* Bt; int M, N, K; };

struct StaticOrder {
    int nM, nN, nwg, G, c;
    __host__ __device__ void init(int M, int N, int G_, int c_) { nM = M / BM; nN = N / BM; nwg = nM * nN; G = G_; c = c_; }
    __host__ __device__ bool next(int i, Unit& u) const {
        const long L = (long)i * G + c; if (L >= nwg) return false;
        int wgid = (int)L; { const int q = nwg / NXCD, r = nwg % NXCD, xcd = wgid % NXCD, off = wgid / NXCD; wgid = (xcd < r ? xcd * (q + 1) : r * (q + 1) + (xcd - r) * q) + off; }
        const int nig = WGM * nN, gid = wgid / nig, fm = gid * WGM, gsz = (nM - fm) < WGM ? (nM - fm) : WGM;
        u.pm = fm + ((wgid % nig) % gsz); u.pn = (wgid % nig) / gsz; return true;
    }
    __device__ __forceinline__ void a_ready(const Unit&) const {}
    __device__ __forceinline__ void done(const Unit&) const {}
};

__device__ __forceinline__ unsigned cvt_pk_bf16(float lo, float hi) { unsigned r; asm volatile("v_cvt_pk_bf16_f32 %0, %1, %2" : "=v"(r) : "v"(lo), "v"(hi)); return r; }
typedef float f32x2 __attribute__((ext_vector_type(2)));
typedef float f32x2v __attribute__((ext_vector_type(2)));
typedef unsigned u32x2 __attribute__((ext_vector_type(2)));
constexpr int ROWS_P = 32768;
__device__ __forceinline__ int row_pos(int r) { return r < ROWS_P ? (r & 8191) : 2048 + (r & 63); }
__device__ __forceinline__ float silu_f(float x) { return x * __builtin_amdgcn_rcpf(1.0f + __builtin_amdgcn_exp2f(-1.4426950408889634f * x)); }

struct EpiIn {
    static constexpr bool PERM = true, AFTER_DRAIN = false;
    bf16_t* base; const float* rstd; const float* rope;
    static constexpr size_t REG = (size_t)34816 * 512;
    __device__ __forceinline__ void operator()(const f32x4 (&acc)[2][2][4][2], const Unit& u, int wr, int wc, int fr, int fq) const {
        const int pn = u.pn, lc0 = wc * 32 + 8 * fq;
        const int rbase = u.pm * BM + wr * 64 + fr;
        if (pn < 4) {
#pragma unroll
            for (int ai = 0; ai < 2; ++ai)
#pragma unroll
                for (int m = 0; m < 4; ++m) { const int r = rbase + ai * HALF + m * 16; const float rs = rstd[r], rs2 = rs * rs;
                    const f32x4 a0 = acc[ai][0][m][0] * acc[ai][1][m][0] * rs2, a1 = acc[ai][0][m][1] * acc[ai][1][m][1] * rs2;
                    u32x4 w; w.x = cvt_pk_bf16(a0[0], a0[1]); w.y = cvt_pk_bf16(a0[2], a0[3]); w.z = cvt_pk_bf16(a1[0], a1[1]); w.w = cvt_pk_bf16(a1[2], a1[3]);
                    *(u32x4*)(base + (size_t)r * 512 + pn * 128 + lc0) = w; }
        } else if (pn >= 6 && pn < 10) {
            bf16_t* dst = base + (size_t)(2 + ((pn - 6) >> 1)) * REG; const int head = 2 * ((pn - 6) & 1) + (lc0 >> 6), i0 = lc0 & 63;
#pragma unroll
            for (int ai = 0; ai < 2; ++ai)
#pragma unroll
                for (int m = 0; m < 4; ++m) { const int r = rbase + ai * HALF + m * 16; const float rs = rstd[r];
                    const f32x4* cs = (const f32x4*)(rope + ((size_t)row_pos(r) * 64 + i0) * 2);
                    const f32x4 c0 = cs[0], c1 = cs[1], c2 = cs[2], c3 = cs[3];
                    const f32x4 x1a = acc[ai][0][m][0] * rs, x1b = acc[ai][0][m][1] * rs, x2a = acc[ai][1][m][0] * rs, x2b = acc[ai][1][m][1] * rs;
                    float o1[8], o2[8];
                    o1[0] = x1a[0] * c0[0] - x2a[0] * c0[1]; o2[0] = x1a[0] * c0[1] + x2a[0] * c0[0];
                    o1[1] = x1a[1] * c0[2] - x2a[1] * c0[3]; o2[1] = x1a[1] * c0[3] + x2a[1] * c0[2];
                    o1[2] = x1a[2] * c1[0] - x2a[2] * c1[1]; o2[2] = x1a[2] * c1[1] + x2a[2] * c1[0];
                    o1[3] = x1a[3] * c1[2] - x2a[3] * c1[3]; o2[3] = x1a[3] * c1[3] + x2a[3] * c1[2];
                    o1[4] = x1b[0] * c2[0] - x2b[0] * c2[1]; o2[4] = x1b[0] * c2[1] + x2b[0] * c2[0];
                    o1[5] = x1b[1] * c2[2] - x2b[1] * c2[3]; o2[5] = x1b[1] * c2[3] + x2b[1] * c2[2];
                    o1[6] = x1b[2] * c3[0] - x2b[2] * c3[1]; o2[6] = x1b[2] * c3[1] + x2b[2] * c3[0];
                    o1[7] = x1b[3] * c3[2] - x2b[3] * c3[3]; o2[7] = x1b[3] * c3[3] + x2b[3] * c3[2];
                    u32x4 w1, w2; w1.x = cvt_pk_bf16(o1[0], o1[1]); w1.y = cvt_pk_bf16(o1[2], o1[3]); w1.z = cvt_pk_bf16(o1[4], o1[5]); w1.w = cvt_pk_bf16(o1[6], o1[7]);
                    w2.x = cvt_pk_bf16(o2[0], o2[1]); w2.y = cvt_pk_bf16(o2[2], o2[3]); w2.z = cvt_pk_bf16(o2[4], o2[5]); w2.w = cvt_pk_bf16(o2[6], o2[7]);
                    bf16_t* p = dst + (size_t)r * 512 + head * 128 + i0;
                    *(u32x4*)p = w1; *(u32x4*)(p + 64) = w2; }
        } else {
            const int reg = (pn < 6) ? 1 : (pn < 12 ? 4 : 5); bf16_t* dst = base + (size_t)reg * REG; const int cb = (pn & 1) * 256; const bool act = pn >= 12;
#pragma unroll
            for (int ai = 0; ai < 2; ++ai)
#pragma unroll
                for (int m = 0; m < 4; ++m) { const int r = rbase + ai * HALF + m * 16; const float rs = rstd[r];
#pragma unroll
                    for (int bj = 0; bj < 2; ++bj) { f32x4 v0 = acc[ai][bj][m][0] * rs, v1 = acc[ai][bj][m][1] * rs;
                        if (act) { v0 = (f32x4){silu_f(v0[0]), silu_f(v0[1]), silu_f(v0[2]), silu_f(v0[3])}; v1 = (f32x4){silu_f(v1[0]), silu_f(v1[1]), silu_f(v1[2]), silu_f(v1[3])}; }
                        u32x4 w; w.x = cvt_pk_bf16(v0[0], v0[1]); w.y = cvt_pk_bf16(v0[2], v0[3]); w.z = cvt_pk_bf16(v1[0], v1[1]); w.w = cvt_pk_bf16(v1[2], v1[3]);
                        *(u32x4*)(dst + (size_t)r * 512 + cb + bj * HALF + lc0) = w; } }
        }
    }
};

struct EpiOut {
    static constexpr bool PERM = false, AFTER_DRAIN = false;
    const float* xp; const float* xs; float* out; bf16_t* Hb; float* ssq;
    __device__ __forceinline__ void operator()(const f32x4 (&acc)[2][2][4][2], const Unit& u, int wr, int wc, int fr, int fq) const {
        const int rbase = u.pm * BM + wr * 64 + fr, col0 = u.pn * BM + wc * 32 + 4 * fq;
#pragma unroll
        for (int ai = 0; ai < 2; ++ai)
#pragma unroll
            for (int m = 0; m < 4; ++m) { const int r = rbase + ai * HALF + m * 16;
                const float* xrow = (r < ROWS_P) ? xp + (size_t)r * 1024 : xs + (size_t)(r - ROWS_P) * 1024;
                float s = 0.f;
#pragma unroll
                for (int bj = 0; bj < 2; ++bj)
#pragma unroll
                    for (int n = 0; n < 2; ++n) { const int c = col0 + bj * HALF + n * 16; const f32x4 h = *(const f32x4*)(xrow + c) + acc[ai][bj][m][n];
                        *(f32x4*)(out + (size_t)r * 1024 + c) = h; u32x2 w; w.x = cvt_pk_bf16(h[0], h[1]); w.y = cvt_pk_bf16(h[2], h[3]);
                        *(u32x2*)(Hb + (size_t)r * 1024 + c) = w; s += (h[0] * h[0] + h[1] * h[1]) + (h[2] * h[2] + h[3] * h[3]); }
                s += __shfl_xor(s, 16); s += __shfl_xor(s, 32);
                if (fq == 0) ssq[(size_t)r * 16 + u.pn * 4 + wc] = s; }
    }
};

struct EpiUp {
    static constexpr bool PERM = true, AFTER_DRAIN = false;
    bf16_t* ACT; const float* ssq; float eps;
    __device__ __forceinline__ void operator()(const f32x4 (&acc)[2][2][4][2], const Unit& u, int wr, int wc, int fr, int fq) const {
        const int rbase = u.pm * BM + wr * 64 + fr, col0 = u.pn * BM + wc * 32 + 8 * fq;
#pragma unroll
        for (int ai = 0; ai < 2; ++ai)
#pragma unroll
            for (int m = 0; m < 4; ++m) { const int r = rbase + ai * HALF + m * 16;
                const f32x4 p = *(const f32x4*)(ssq + (size_t)r * 16 + 4 * fq); float s = (p[0] + p[1]) + (p[2] + p[3]);
                s += __shfl_xor(s, 16); s += __shfl_xor(s, 32);
                const float rs = __builtin_amdgcn_rsqf(s * (1.0f / 1024.0f) + eps);
#pragma unroll
                for (int bj = 0; bj < 2; ++bj) { f32x4 v0 = acc[ai][bj][m][0] * rs, v1 = acc[ai][bj][m][1] * rs;
#pragma unroll
                    for (int j = 0; j < 4; ++j) { const float a = fmaxf(v0[j], 0.f), b = fmaxf(v1[j], 0.f); v0[j] = a * a; v1[j] = b * b; }
                    u32x4 w; w.x = cvt_pk_bf16(v0[0], v0[1]); w.y = cvt_pk_bf16(v0[2], v0[3]); w.z = cvt_pk_bf16(v1[0], v1[1]); w.w = cvt_pk_bf16(v1[2], v1[3]);
                    *(u32x4*)(ACT + (size_t)r * 4096 + col0 + bj * HALF) = w; } }
    }
};

struct EpiDown {
    static constexpr bool PERM = false, AFTER_DRAIN = false;
    float* out; float* ssq;
    __device__ __forceinline__ void operator()(const f32x4 (&acc)[2][2][4][2], const Unit& u, int wr, int wc, int fr, int fq) const {
        const int rbase = u.pm * BM + wr * 64 + fr, col0 = u.pn * BM + wc * 32 + 4 * fq;
#pragma unroll
        for (int ai = 0; ai < 2; ++ai)
#pragma unroll
            for (int m = 0; m < 4; ++m) { const int r = rbase + ai * HALF + m * 16; float s = 0.f;
#pragma unroll
                for (int bj = 0; bj < 2; ++bj)
#pragma unroll
                    for (int n = 0; n < 2; ++n) { float* p = out + (size_t)r * 1024 + col0 + bj * HALF + n * 16; const f32x4 h = *(const f32x4*)p + acc[ai][bj][m][n];
                        *(f32x4*)p = h; s += (h[0] * h[0] + h[1] * h[1]) + (h[2] * h[2] + h[3] * h[3]); }
                s += __shfl_xor(s, 16); s += __shfl_xor(s, 32);
                if (fq == 0) ssq[(size_t)r * 16 + u.pn * 4 + wc] = s; }
    }
};
template <class Epi, class Sched, bool ALIGN_EPI = false, bool SP2 = false>
__device__ __forceinline__ void gemm_phase(PG8_LAS unsigned char* lds, const Gemm g, const Sched& S, const Epi& E) {
    const int tid = threadIdx.x, wid = __builtin_amdgcn_readfirstlane(tid >> 6), lane = tid & 63, wr = wid >> 2, wc = wid & 3, fr = lane & 15, fq = lane >> 4;
    const int K = g.K, nt = K / BK;
    unsigned voffA[2], voffB[2];
#pragma unroll
    for (int i = 0; i < 2; ++i) { int R, C; stage_rc(tid * 16 + i * 8192, R, C); const int Rb = Epi::PERM ? ((R & ~31) + perm32(R & 31)) : R;
        voffA[i] = (unsigned)(R * K + C) * 2u; voffB[i] = (unsigned)(Rb * K + C) * 2u; }
    const size_t kstep = (size_t)(BK * 2);
    const size_t hstep = (size_t)HALF * K * 2;
    const size_t tstep = 2 * hstep;
    const unsigned ldsw = (unsigned)wid * 1024u;
    const int aoff = lds_byte(wr * 64 + fr, fq * 8), boff = lds_byte(wc * 32 + fr, fq * 8);
#define PG8_SA(b, h) (((b) * 2 + (h)) * HTB)
#define PG8_SB(b, h) ((4 + (b) * 2 + (h)) * HTB)
#define PG8_STAGE(bufoff, gbase, voff) do { _Pragma("unroll") for (int _i = 0; _i < 2; ++_i) \
        __builtin_amdgcn_global_load_lds((const unsigned*)((const char*)(gbase) + (voff)[_i]), (PG8_LAS unsigned*)(lds + (bufoff) + ldsw + _i * 8192), 16, 0, 0); } while (0)
#define PG8_LDA(dst, b, h) do { _Pragma("unroll") for (int m = 0; m < 4; ++m) _Pragma("unroll") for (int k = 0; k < 2; ++k) dst[m][k] = *(const PG8_LAS bf16x8*)(lds + PG8_SA(b, h) + aoff + m * 2048 + k * 1024); } while (0)
#define PG8_LDB(dst, b, h) do { _Pragma("unroll") for (int n = 0; n < 2; ++n) _Pragma("unroll") for (int k = 0; k < 2; ++k) dst[n][k] = *(const PG8_LAS bf16x8*)(lds + PG8_SB(b, h) + boff + n * 2048 + k * 1024); } while (0)
#define PG8_MMA(ai, bj, At, Bt) do { __builtin_amdgcn_s_setprio(1); _Pragma("unroll") for (int m = 0; m < 4; ++m) _Pragma("unroll") for (int n = 0; n < 2; ++n) _Pragma("unroll") for (int k = 0; k < 2; ++k) \
        acc[ai][bj][m][n] = __builtin_amdgcn_mfma_f32_16x16x32_bf16(Bt[n][k], At[m][k], acc[ai][bj][m][n], 0, 0, 0); __builtin_amdgcn_s_setprio(0); } while (0)
#define PG8_WAIT_V(n) asm volatile("s_waitcnt vmcnt(" #n ")" ::: "memory")
#define PG8_WAIT_L(n) asm volatile("s_waitcnt lgkmcnt(" #n ")" ::: "memory")
#define PG8_BAR __builtin_amdgcn_s_barrier()
#define PG8_SCHED __builtin_amdgcn_sched_barrier(0)
    Unit cur, nxt; int ui = 0;
    if (!S.next(0, cur)) return;
    f32x4 acc[2][2][4][2];
#pragma unroll
    for (int a = 0; a < 2; ++a)
#pragma unroll
        for (int b = 0; b < 2; ++b)
#pragma unroll
            for (int m = 0; m < 4; ++m)
#pragma unroll
                for (int n = 0; n < 2; ++n) acc[a][b][m][n] = (f32x4){0.f, 0.f, 0.f, 0.f};
    bf16x8 At[4][2], B0[2][2], B1[2][2];
    const char* cA = (const char*)g.A + (size_t)cur.pm * tstep; const char* cB = (const char*)g.Bt + (size_t)cur.pn * tstep;
    S.a_ready(cur);
    if constexpr (SP2) {
        PG8_STAGE(PG8_SB(0, 0), cB, voffB); PG8_STAGE(PG8_SB(0, 1), cB + hstep, voffB); PG8_STAGE(PG8_SA(0, 0), cA, voffA); PG8_STAGE(PG8_SA(0, 1), cA + hstep, voffA);
        if (wr == 1) PG8_BAR;
        PG8_WAIT_V(2); PG8_BAR;
        PG8_STAGE(PG8_SB(1, 0), cB + kstep, voffB); PG8_STAGE(PG8_SA(1, 0), cA + kstep, voffA); PG8_STAGE(PG8_SB(1, 1), cB + hstep + kstep, voffB);
        PG8_WAIT_V(6); PG8_BAR;
    } else {
        PG8_STAGE(PG8_SB(0, 0), cB, voffB); PG8_STAGE(PG8_SA(0, 0), cA, voffA); PG8_STAGE(PG8_SB(0, 1), cB + hstep, voffB); PG8_STAGE(PG8_SA(0, 1), cA + hstep, voffA);
        if (wr == 1) PG8_BAR;
        PG8_WAIT_V(4); PG8_BAR;
        PG8_STAGE(PG8_SB(1, 0), cB + kstep, voffB); PG8_STAGE(PG8_SA(1, 0), cA + kstep, voffA); PG8_STAGE(PG8_SB(1, 1), cB + hstep + kstep, voffB);
        PG8_WAIT_V(6); PG8_BAR;
    }
    for (;;) {
        const bool has_next = S.next(ui + 1, nxt);
        const char* nA = has_next ? (const char*)g.A + (size_t)nxt.pm * tstep : cA; const char* nB = has_next ? (const char*)g.Bt + (size_t)nxt.pn * tstep : cB;
        for (int t = 0; t < nt; t += 2) {
            const bool last = (t == nt - 2);
            const char* a1 = cA + (size_t)(t + 1) * kstep;
            const char* a2 = last ? nA : cA + (size_t)(t + 2) * kstep; const char* b2 = last ? nB : cB + (size_t)(t + 2) * kstep;
            const char* a3 = a2 + kstep; const char* b3 = b2 + kstep;
            if (last && has_next) S.a_ready(nxt);
            if constexpr (SP2) {
            PG8_LDB(B0, 0, 0); PG8_LDB(B1, 0, 1); PG8_SCHED; PG8_LDA(At, 0, 0); PG8_STAGE(PG8_SA(1, 1), a1 + hstep, voffA);
            PG8_WAIT_V(8); PG8_WAIT_L(0); PG8_BAR; PG8_MMA(0, 0, At, B0); PG8_MMA(0, 1, At, B1); PG8_BAR; PG8_SCHED;
            PG8_LDA(At, 0, 1); PG8_STAGE(PG8_SB(0, 0), b2, voffB); PG8_STAGE(PG8_SB(0, 1), b2 + hstep, voffB); PG8_STAGE(PG8_SA(0, 0), a2, voffA);
            PG8_WAIT_V(8); PG8_WAIT_L(0); PG8_BAR; PG8_MMA(1, 0, At, B0); PG8_MMA(1, 1, At, B1); PG8_BAR; PG8_SCHED;
            PG8_LDB(B0, 1, 0); PG8_LDB(B1, 1, 1); PG8_SCHED; PG8_LDA(At, 1, 0); PG8_STAGE(PG8_SA(0, 1), a2 + hstep, voffA);
            PG8_WAIT_V(8); PG8_WAIT_L(0); PG8_BAR; PG8_MMA(0, 0, At, B0); PG8_MMA(0, 1, At, B1); PG8_BAR; PG8_SCHED;
            PG8_LDA(At, 1, 1); PG8_STAGE(PG8_SB(1, 0), b3, voffB); PG8_STAGE(PG8_SB(1, 1), b3 + hstep, voffB); PG8_STAGE(PG8_SA(1, 0), a3, voffA);
            PG8_WAIT_V(8); PG8_WAIT_L(0); PG8_BAR; PG8_MMA(1, 0, At, B0); PG8_MMA(1, 1, At, B1); PG8_BAR; PG8_SCHED;
            } else {
            PG8_LDB(B0, 0, 0); PG8_SCHED; PG8_LDA(At, 0, 0); PG8_STAGE(PG8_SA(1, 1), a1 + hstep, voffA);
            PG8_WAIT_L(8); PG8_BAR; PG8_WAIT_L(0); PG8_MMA(0, 0, At, B0); PG8_BAR; PG8_SCHED;
            PG8_LDB(B1, 0, 1); PG8_STAGE(PG8_SB(0, 0), b2, voffB);
            PG8_BAR; PG8_WAIT_L(0); PG8_MMA(0, 1, At, B1); PG8_BAR;
            PG8_LDA(At, 0, 1); PG8_STAGE(PG8_SA(0, 0), a2, voffA);
            PG8_BAR; PG8_WAIT_L(0); PG8_MMA(1, 0, At, B0); PG8_BAR; PG8_SCHED;
            PG8_STAGE(PG8_SB(0, 1), b2 + hstep, voffB);
            PG8_WAIT_V(6); PG8_BAR; PG8_MMA(1, 1, At, B1); PG8_BAR;
            PG8_LDB(B0, 1, 0); PG8_SCHED; PG8_LDA(At, 1, 0); PG8_STAGE(PG8_SA(0, 1), a2 + hstep, voffA);
            PG8_WAIT_L(8); PG8_BAR; PG8_WAIT_L(0); PG8_MMA(0, 0, At, B0); PG8_BAR; PG8_SCHED;
            PG8_LDB(B1, 1, 1); PG8_STAGE(PG8_SB(1, 0), b3, voffB);
            PG8_BAR; PG8_WAIT_L(0); PG8_MMA(0, 1, At, B1); PG8_BAR;
            PG8_LDA(At, 1, 1); PG8_STAGE(PG8_SA(1, 0), a3, voffA);
            PG8_BAR; PG8_WAIT_L(0); PG8_MMA(1, 0, At, B0); PG8_BAR; PG8_SCHED;
            PG8_STAGE(PG8_SB(1, 1), b3 + hstep, voffB);
            PG8_WAIT_V(6); PG8_BAR; PG8_MMA(1, 1, At, B1); PG8_BAR;
            }
        }
        if constexpr (ALIGN_EPI) { if (wr == 0) PG8_BAR; }
        if constexpr (!Epi::AFTER_DRAIN) { E(acc, cur, wr, wc, fr, fq); S.done(cur); }
        if (!has_next) break;
#pragma unroll
        for (int a = 0; a < 2; ++a)
#pragma unroll
            for (int b = 0; b < 2; ++b)
#pragma unroll
                for (int m = 0; m < 4; ++m)
#pragma unroll
                    for (int n = 0; n < 2; ++n) acc[a][b][m][n] = (f32x4){0.f, 0.f, 0.f, 0.f};
        cur = nxt; cA = nA; cB = nB; ++ui;
        if constexpr (ALIGN_EPI) { if (wr == 1) PG8_BAR; }
    }
    PG8_WAIT_V(0);
    if constexpr (!ALIGN_EPI) { if (wr == 0) PG8_BAR; }
    PG8_BAR;
    if constexpr (Epi::AFTER_DRAIN) { E.fused(acc, cur, wr, wc, fr, fq, lds, wid, lane); S.done(cur); }
#undef PG8_SA
#undef PG8_SB
#undef PG8_STAGE
#undef PG8_LDA
#undef PG8_LDB
#undef PG8_MMA
#undef PG8_WAIT_V
#undef PG8_WAIT_L
#undef PG8_BAR
#undef PG8_SCHED
}
}
#ifndef PG8_SP2
#define PG8_SP2 true
#endif
#define GAS __attribute__((address_space(1)))
#define LAS __attribute__((address_space(3)))
typedef unsigned short bf16;
typedef unsigned v4u __attribute__((ext_vector_type(4)));
typedef float f32x4 __attribute__((ext_vector_type(4)));
typedef short bf16x8 __attribute__((ext_vector_type(8)));
typedef GAS unsigned gu32;
typedef GAS unsigned long long gu64;
#define RLX_AGENT __ATOMIC_RELAXED, __HIP_MEMORY_SCOPE_AGENT
#define LDS_WAIT() asm volatile("s_waitcnt lgkmcnt(0)" ::: "memory")
#define VM_WAIT() asm volatile("s_waitcnt vmcnt(0)" ::: "memory")
__device__ __forceinline__ unsigned long long rt() { return __builtin_amdgcn_s_memrealtime(); }
__device__ __forceinline__ unsigned f2bf(float f) { unsigned u = __builtin_bit_cast(unsigned, f); return (u + 0x7fffu + ((u >> 16) & 1u)) >> 16; }
__device__ __forceinline__ unsigned pk2(float lo, float hi) { return f2bf(lo) | (f2bf(hi) << 16); }

#define XB_TMO      128
#define XB_XCNT(j)  (256  + 64 * (j))
#define XB_XSUB(j)  (1280 + 64 * (j))
#define XB_XGEN(j)  (2304 + 64 * (j))
#define XB_TOP      3328
#define XB_TOPGEN   3392
#define XCD_BAR_WORDS 3456
#define XB_SPIN_CAP (1u << 18)

__device__ __forceinline__ unsigned xb_ld(unsigned* p)              { return __hip_atomic_load(p, __ATOMIC_RELAXED, __HIP_MEMORY_SCOPE_AGENT); }
__device__ __forceinline__ unsigned xb_add(unsigned* p, unsigned v) { return __hip_atomic_fetch_add(p, v, __ATOMIC_RELAXED, __HIP_MEMORY_SCOPE_AGENT); }
__device__ __forceinline__ unsigned xb_xcc_id() { return (unsigned)__builtin_amdgcn_s_getreg((3 << 11) | 20) & 0xFu; }
#define XB_SPIN(cond, bar) do { unsigned _sp = 0; while (cond) { __builtin_amdgcn_s_sleep(1); \
    if ((++_sp & 255u) == 0u) { if (xb_ld(&(bar)[XB_TMO])) break; if (_sp > XB_SPIN_CAP) { atomicAdd(&(bar)[XB_TMO], 1u); break; } } } } while (0)

struct XcdBarrier {
    unsigned* bar; unsigned x;
    volatile LAS unsigned* st;
};

__device__ __forceinline__ XcdBarrier xcd_barrier_post(unsigned* bar, volatile LAS unsigned* st) {
    XcdBarrier b; b.bar = bar; b.x = xb_xcc_id(); b.st = st;
    if (threadIdx.x == 0) (void)xb_add(&bar[XB_XCNT(b.x)], 1u);
    return b;
}
__device__ __forceinline__ void xcd_barrier_complete(unsigned* bar, unsigned x, unsigned& nloc, unsigned& nx) {
    const unsigned G = gridDim.x * gridDim.y * gridDim.z;
    unsigned sum, cnt, mine, sp = 0u;
    for (;;) {
        sum = 0u; cnt = 0u; mine = 0u;
#pragma unroll
        for (unsigned j = 0; j < 16; ++j) { const unsigned c = xb_ld(&bar[XB_XCNT(j)]); sum += c; cnt += (c > 0u) ? 1u : 0u; mine = (j == x) ? c : mine; }
        if (sum == G) break;
        __builtin_amdgcn_s_sleep(1);
        if ((++sp & 255u) == 0u) { if (xb_ld(&bar[XB_TMO])) break; if (sp > XB_SPIN_CAP) { atomicAdd(&bar[XB_TMO], 1u); break; } }
    }
    nloc = mine > 0u ? mine : 1u; nx = cnt > 0u ? cnt : 1u;
}

__device__ __forceinline__ void xcd_barrier(const XcdBarrier& b) {
    asm volatile("s_waitcnt vmcnt(0)" ::: "memory");
    __syncthreads();
    if (threadIdx.x == 0) {
        unsigned* bar = b.bar;
        __builtin_amdgcn_s_waitcnt(0);
        unsigned nloc = b.st[0], nx = b.st[1];
        if (nloc == 0u) { xcd_barrier_complete(bar, b.x, nloc, nx); b.st[0] = nloc; b.st[1] = nx; }
        const unsigned old = xb_add(&bar[XB_XSUB(b.x)], 1u);
        const unsigned gen = old / nloc;
        if (old + 1u == (gen + 1u) * nloc) {
            __builtin_amdgcn_fence(__ATOMIC_RELEASE, "agent");
            asm volatile("s_waitcnt vmcnt(0)" ::: "memory");
            const unsigned og = xb_add(&bar[XB_TOP], 1u);
            const unsigned tg = og / nx;
            if (og + 1u == (tg + 1u) * nx) xb_add(&bar[XB_TOPGEN], 1u);
            else XB_SPIN(xb_ld(&bar[XB_TOPGEN]) == tg, bar);
            __builtin_amdgcn_fence(__ATOMIC_ACQUIRE, "agent");
            xb_add(&bar[XB_XGEN(b.x)], 1u);
            asm volatile("s_waitcnt vmcnt(0)" ::: "memory");
        } else {
            XB_SPIN(xb_ld(&bar[XB_XGEN(b.x)]) == gen, bar);
            __builtin_amdgcn_fence(__ATOMIC_ACQUIRE, "agent");
            asm volatile("s_waitcnt vmcnt(0)" ::: "memory");
        }
    }
    __syncthreads();
}


constexpr int NWAVES = 8;
constexpr int DM = 1024, NBP = 4, SEQ = 8192, NBS = 32, DSEQ = 64, NMETA = 16;
constexpr int DCONV = 512, NH = 4, DH = 128, DRET = 512, DFF = 4096, DIN = 3584;
constexpr int MP = NBP * SEQ, MS = NBS * DSEQ, M = MP + MS;
constexpr float NORM_EPS = 1e-6f, GN_EPS = 1e-5f;
static_assert(MP == pg8::ROWS_P && M % 256 == 0, "row geometry");
constexpr size_t O_Y = 0, O_CONVP = (size_t)M * DM, O_RETP = O_CONVP + NBP * 2 * DCONV, O_CONVS = O_RETP + (size_t)NBP * NH * DH * DH, O_RETS = O_CONVS + NBS * 2 * DCONV,
                 O_END = O_RETS + (size_t)NBS * NH * DH * DH;
constexpr size_t MiB = 1u << 20;
constexpr size_t WS_CTL = 0, CTL_ZERO_BYTES = 1 * MiB;
constexpr size_t WS_RSTD1 = 1 * MiB, WS_SSQ1 = 2 * MiB, WS_SSQ2 = 5 * MiB, WS_ROPE = 8 * MiB, WS_META = 12 * MiB;
constexpr size_t WS_WIN = 16 * MiB, WS_WOUT = 24 * MiB, WS_WUP = 26 * MiB, WS_WDN = 34 * MiB;
constexpr size_t WS_XB = 48 * MiB;
constexpr size_t WS_U = 116 * MiB, WS_BG = 150 * MiB, WS_Q = 184 * MiB, WS_K = 218 * MiB, WS_V = 252 * MiB, WS_SG = 286 * MiB;
constexpr size_t WS_MIX = 320 * MiB;
constexpr size_t WS_ACT = 116 * MiB;
constexpr size_t WS_TG = 388 * MiB, WS_GG = 404 * MiB, WS_SMETA = 420 * MiB;
constexpr size_t WS_END = 421 * MiB;
static_assert(WS_BG - WS_U == (size_t)M * 512 * 2 && WS_Q - WS_BG == WS_BG - WS_U && WS_K - WS_Q == WS_BG - WS_U && WS_V - WS_K == WS_BG - WS_U && WS_SG - WS_V == WS_BG - WS_U, "six bf16 regions back to back");
static_assert(WS_XB + (size_t)M * DM * 2 <= WS_U && WS_SG + (size_t)M * 512 * 2 <= WS_MIX && WS_MIX + (size_t)M * DM * 2 <= WS_TG && WS_ACT + (size_t)M * DFF * 2 <= WS_TG, "ws map");
static_assert(WS_SSQ1 + (size_t)M * 16 * 4 <= WS_SSQ2 && WS_SSQ2 + (size_t)M * 16 * 4 <= WS_ROPE && WS_ROPE + (size_t)8192 * 64 * 8 <= WS_META, "ws map small");
constexpr int CW_TMO = 0, CW_BAR = 4096;
constexpr int RING_OFF = 0, RING_BYTES = 131072, LDSCTL_OFF = RING_BYTES, MISC_OFF = LDSCTL_OFF + 320, LDS_BYTES = 147456;

struct Frame {
    LAS unsigned char* lds;
    volatile LAS unsigned* MISC;
    gu32* ctl;
    int tid, lane, wave, vcu, G;
    const float* in[14];
    float* out;
    unsigned char* ws;
};
__device__ __forceinline__ float wave_sum(float v) {
#pragma unroll
    for (int o = 1; o < 64; o <<= 1) v += __shfl_xor(v, o);
    return v;
}
__device__ __forceinline__ float bf2f(unsigned short b) { return __builtin_bit_cast(float, (unsigned)b << 16); }

__device__ __forceinline__ int win_src_col(int n0, float& sc) {
    const int pn = n0 >> 8, lc = n0 & 255; sc = 1.0f;
    if (pn < 4) return (lc < 128) ? (128 * pn + lc) : (1024 + 128 * pn + (lc - 128));
    if (pn < 6) return 512 + 256 * (pn - 4) + lc;
    if (pn < 10) { const int isk = (pn >= 8) ? 1 : 0, hp = (pn - 6) & 1, half = lc >> 7, l2 = lc & 127, head = 2 * hp + (l2 >> 6), i = l2 & 63; if (isk) sc = 0.08838834764831845f;
        return 1536 + 512 * isk + 128 * head + 64 * half + i; }
    if (pn < 12) return 2560 + 256 * (pn - 10) + lc;
    return 3072 + 256 * (pn - 12) + lc;
}
__device__ __forceinline__ void p0_transpose_item(const float* W, int K, int N, bf16* WT, int k0, int n0, int src0, const float* ks, float cs, LAS float* scr, int lane) {
#pragma unroll 8
    for (int i = 0; i < 32; ++i) { const int kk = 2 * i + (lane >> 5); const float s = ks ? ks[k0 + kk] * cs : cs; scr[kk * 33 + (lane & 31)] = W[(size_t)(k0 + kk) * N + src0 + (lane & 31)] * s; }
    LDS_WAIT(); asm volatile("" ::: "memory");
    const int c = lane & 7;
#pragma unroll
    for (int j = 0; j < 4; ++j) { const int n = (lane >> 3) + 8 * j; const LAS float* s = scr + (8 * c) * 33 + n;
        v4u o; o.x = pk2(s[0 * 33], s[1 * 33]); o.y = pk2(s[2 * 33], s[3 * 33]); o.z = pk2(s[4 * 33], s[5 * 33]); o.w = pk2(s[6 * 33], s[7 * 33]);
        *(GAS v4u*)(WT + (size_t)(n0 + n) * K + k0 + 8 * c) = o; }
    LDS_WAIT(); asm volatile("" ::: "memory");
}
__device__ __forceinline__ void x_row_to_bf16(int lane, const float* xrow, bf16* orow, float* rstd_out) {
    const GAS f32x4* xr = (const GAS f32x4*)xrow + lane;
    f32x4 v[4]; float s = 0.f;
#pragma unroll
    for (int j = 0; j < 4; ++j) { v[j] = xr[64 * j]; s += (v[j].x * v[j].x + v[j].y * v[j].y) + (v[j].z * v[j].z + v[j].w * v[j].w); }
    s = wave_sum(s);
    GAS unsigned long long* o8 = (GAS unsigned long long*)orow + lane;
#pragma unroll
    for (int j = 0; j < 4; ++j) o8[64 * j] = (unsigned long long)pk2(v[j].x, v[j].y) | ((unsigned long long)pk2(v[j].z, v[j].w) << 32);
    if (lane == 0) *rstd_out = 1.0f / sqrtf(s * (1.0f / DM) + NORM_EPS);
}
__device__ __forceinline__ void p0_prologue(Frame& F) {
    LAS float* scr = (LAS float*)(F.lds + RING_OFF + F.wave * 16384);
    const int gw = F.vcu * NWAVES + F.wave, NGW = F.G * NWAVES;
    const float* w_in = F.in[6]; const float* w_out = F.in[9]; const float* w_up = F.in[11]; const float* w_dn = F.in[12];
    bf16* WIN = (bf16*)(F.ws + WS_WIN); bf16* WOUT = (bf16*)(F.ws + WS_WOUT); bf16* WUP = (bf16*)(F.ws + WS_WUP); bf16* WDN = (bf16*)(F.ws + WS_WDN);
    constexpr int I_IN = (DM / 64) * (DIN / 32), I_OUT = (DM / 64) * (DM / 32), I_UP = (DM / 64) * (DFF / 32), I_DN = (DFF / 64) * (DM / 32);
    constexpr int NITEMS = I_IN + I_OUT + I_UP + I_DN;
    for (int it = gw; it < NITEMS; it += NGW) {
        int r = it;
        if (r < I_IN) { const int nblk = DIN / 32, kb = r / nblk, nb = r % nblk; float cs; const int src0 = win_src_col(32 * nb, cs);
            p0_transpose_item(w_in, DM, DIN, WIN, 64 * kb, 32 * nb, src0, F.in[5], cs, scr, F.lane); continue; } r -= I_IN;
        if (r < I_OUT) { const int nblk = DM / 32, kb = r / nblk, nb = r % nblk; p0_transpose_item(w_out, DM, DM, WOUT, 64 * kb, 32 * nb, 32 * nb, nullptr, 1.0f, scr, F.lane); continue; } r -= I_OUT;
        if (r < I_UP) { const int nblk = DFF / 32, kb = r / nblk, nb = r % nblk; p0_transpose_item(w_up, DM, DFF, WUP, 64 * kb, 32 * nb, 32 * nb, F.in[10], 1.0f, scr, F.lane); continue; } r -= I_UP;
        { const int nblk = DM / 32, kb = r / nblk, nb = r % nblk; p0_transpose_item(w_dn, DFF, DM, WDN, 64 * kb, 32 * nb, 32 * nb, nullptr, 1.0f, scr, F.lane); }
    }
    bf16* XB = (bf16*)(F.ws + WS_XB); float* RS = (float*)(F.ws + WS_RSTD1);
    for (int m = gw; m < M; m += NGW) { const float* xrow = (m < MP) ? F.in[0] + (size_t)m * DM : F.in[1] + (size_t)(m - MP) * DM; x_row_to_bf16(F.lane, xrow, XB + (size_t)m * DM, RS + m); }
    float* ROPE = (float*)(F.ws + WS_ROPE);
    for (int e = (F.vcu * NWAVES * 64) + F.tid; e < 8192 * 64; e += F.G * NWAVES * 64) { const int pos = e >> 6, i = e & 63;
        const float invf = (float)exp2(-(double)i * (13.287712379549449 / 64.0));
        const double rev = (double)((float)pos * invf) * 0.15915494309189535;
        const float fr = (float)(rev - __builtin_rint(rev));
        ROPE[2 * e] = __builtin_amdgcn_cosf(fr); ROPE[2 * e + 1] = __builtin_amdgcn_sinf(fr); }
}

__device__ __forceinline__ void meta_proj(Frame& F) {
    LAS float* hm = (LAS float*)(F.lds + RING_OFF);
    const float* meta = F.in[4];
    for (int rr = 0; rr < 2; ++rr) { const int row = F.wave * 2 + rr; const GAS f32x4* xr = (const GAS f32x4*)(meta + (size_t)row * DM) + F.lane;
        f32x4 v[4]; float s = 0.f;
#pragma unroll
        for (int j = 0; j < 4; ++j) { v[j] = xr[64 * j]; s += (v[j].x * v[j].x + v[j].y * v[j].y) + (v[j].z * v[j].z + v[j].w * v[j].w); }
        const float rs = 1.0f / sqrtf(wave_sum(s) * (1.0f / DM) + NORM_EPS);
#pragma unroll
        for (int j = 0; j < 4; ++j) *(LAS f32x4*)(hm + row * DM + 4 * (F.lane + 64 * j)) = v[j] * rs; }
    LDS_WAIT(); __syncthreads();
    const bf16* WIN = (const bf16*)(F.ws + WS_WIN); float* MPJ = (float*)(F.ws + WS_META);
    const int gw = F.vcu * NWAVES + F.wave, NGW = F.G * NWAVES;
    for (int n = gw; n < DIN; n += NGW) {
        const GAS v4u* wp = (const GAS v4u*)(WIN + (size_t)n * DM + 16 * F.lane); const v4u w0 = wp[0], w1 = wp[1];
        float wv[16];
        wv[0] = bf2f(w0.x & 0xffff); wv[1] = bf2f(w0.x >> 16); wv[2] = bf2f(w0.y & 0xffff); wv[3] = bf2f(w0.y >> 16); wv[4] = bf2f(w0.z & 0xffff); wv[5] = bf2f(w0.z >> 16); wv[6] = bf2f(w0.w & 0xffff); wv[7] = bf2f(w0.w >> 16);
        wv[8] = bf2f(w1.x & 0xffff); wv[9] = bf2f(w1.x >> 16); wv[10] = bf2f(w1.y & 0xffff); wv[11] = bf2f(w1.y >> 16); wv[12] = bf2f(w1.z & 0xffff); wv[13] = bf2f(w1.z >> 16); wv[14] = bf2f(w1.w & 0xffff); wv[15] = bf2f(w1.w >> 16);
        float res = 0.f;
#pragma unroll 2
        for (int row = 0; row < 16; ++row) { const LAS f32x4* h = (const LAS f32x4*)(hm + row * DM + 16 * F.lane); float a = 0.f;
#pragma unroll
            for (int q = 0; q < 4; ++q) { const f32x4 hv = h[q]; a += hv.x * wv[4 * q] + hv.y * wv[4 * q + 1] + hv.z * wv[4 * q + 2] + hv.w * wv[4 * q + 3]; }
            a = wave_sum(a); if (F.lane == row) res = a; }
        if (F.lane < 16) MPJ[(size_t)F.lane * DIN + n] = res;
    }
}
__device__ __forceinline__ int mcol_xt(int c) { return 256 * (c >> 7) + (c & 127); }
__device__ __forceinline__ int mcol_cg(int c) { return 256 * (c >> 7) + 128 + (c & 127); }
__device__ __forceinline__ int mcol_k(int head, int d) { return 256 * (8 + (head >> 1)) + 128 * (d >> 6) + 64 * (head & 1) + (d & 63); }
__device__ __forceinline__ int mcol_v(int head, int e) { return 2560 + 128 * head + e; }

__device__ __forceinline__ void conv_phase(Frame& F) {
    const bf16* U = (const bf16*)(F.ws + WS_U); const bf16* BG = (const bf16*)(F.ws + WS_BG); bf16* MIX = (bf16*)(F.ws + WS_MIX);
    const float* MPJ = (const float*)(F.ws + WS_META); const float* cw = F.in[7]; const float* sconv = F.in[2];
    const int nthr = F.G * NWAVES * 64;
    for (int item = F.vcu * NWAVES * 64 + F.tid; item < M * 64; item += nthr) {
        const int r = item >> 6, c8 = (item & 63) * 8; const bool pr = r < MP; const int t = pr ? (r & 8191) : (r & 63), T = pr ? SEQ : DSEQ;
        float u0[8], u1[8], u2[8], bg[8];
        { const v4u a = *(const GAS v4u*)(U + (size_t)r * 512 + c8); u0[0] = bf2f(a.x & 0xffff); u0[1] = bf2f(a.x >> 16); u0[2] = bf2f(a.y & 0xffff); u0[3] = bf2f(a.y >> 16); u0[4] = bf2f(a.z & 0xffff); u0[5] = bf2f(a.z >> 16); u0[6] = bf2f(a.w & 0xffff); u0[7] = bf2f(a.w >> 16); }
        { const v4u a = *(const GAS v4u*)(BG + (size_t)r * 512 + c8); bg[0] = bf2f(a.x & 0xffff); bg[1] = bf2f(a.x >> 16); bg[2] = bf2f(a.y & 0xffff); bg[3] = bf2f(a.y >> 16); bg[4] = bf2f(a.z & 0xffff); bg[5] = bf2f(a.z >> 16); bg[6] = bf2f(a.w & 0xffff); bg[7] = bf2f(a.w >> 16); }
        if (t >= 1) { const v4u a = *(const GAS v4u*)(U + (size_t)(r - 1) * 512 + c8); u1[0] = bf2f(a.x & 0xffff); u1[1] = bf2f(a.x >> 16); u1[2] = bf2f(a.y & 0xffff); u1[3] = bf2f(a.y >> 16); u1[4] = bf2f(a.z & 0xffff); u1[5] = bf2f(a.z >> 16); u1[6] = bf2f(a.w & 0xffff); u1[7] = bf2f(a.w >> 16); }
        if (t >= 2) { const v4u a = *(const GAS v4u*)(U + (size_t)(r - 2) * 512 + c8); u2[0] = bf2f(a.x & 0xffff); u2[1] = bf2f(a.x >> 16); u2[2] = bf2f(a.y & 0xffff); u2[3] = bf2f(a.y >> 16); u2[4] = bf2f(a.z & 0xffff); u2[5] = bf2f(a.z >> 16); u2[6] = bf2f(a.w & 0xffff); u2[7] = bf2f(a.w >> 16); }
        if (t < 2) {
#pragma unroll
            for (int j = 0; j < 8; ++j) { const int c = c8 + j; float h0, h1;
                if (pr) { h0 = MPJ[(size_t)14 * DIN + mcol_xt(c)] * MPJ[(size_t)14 * DIN + mcol_cg(c)]; h1 = MPJ[(size_t)15 * DIN + mcol_xt(c)] * MPJ[(size_t)15 * DIN + mcol_cg(c)]; }
                else { const int s = (r - MP) >> 6; h0 = sconv[((size_t)s * 2 + 0) * DCONV + c]; h1 = sconv[((size_t)s * 2 + 1) * DCONV + c]; }
                if (t == 0) { u1[j] = h1; u2[j] = h0; } else { u2[j] = h1; } }
        }
        float o[8];
#pragma unroll
        for (int j = 0; j < 8; ++j) { const int c = c8 + j; o[j] = bg[j] * (cw[c] * u2[j] + cw[DCONV + c] * u1[j] + cw[2 * DCONV + c] * u0[j]); }
        v4u w; w.x = pk2(o[0], o[1]); w.y = pk2(o[2], o[3]); w.z = pk2(o[4], o[5]); w.w = pk2(o[6], o[7]);
        *(GAS v4u*)(MIX + (size_t)r * DM + c8) = w;
        if (t >= T - 2) { float* dst = pr ? F.out + O_CONVP + ((size_t)(r >> 13) * 2 + (t - (T - 2))) * DCONV + c8 : F.out + O_CONVS + ((size_t)((r - MP) >> 6) * 2 + (t - (T - 2))) * DCONV + c8;
            *(f32x4*)dst = (f32x4){u0[0], u0[1], u0[2], u0[3]}; *(f32x4*)(dst + 4) = (f32x4){u0[4], u0[5], u0[6], u0[7]}; }
    }
}

namespace ret {
constexpr int QS = 0, KS = 17408, KT = 34816, VT = 53248, AS = 71680, ST = 80896;
constexpr int QSTR = 272, TSTR = 144;
__device__ __forceinline__ unsigned short el16(const v4u& w, int k) { const unsigned x = (k >> 1) == 0 ? w.x : (k >> 1) == 1 ? w.y : (k >> 1) == 2 ? w.z : w.w; return (k & 1) ? (unsigned short)(x >> 16) : (unsigned short)(x & 0xffffu); }
typedef unsigned long long u64;
typedef float f32x2 __attribute__((ext_vector_type(2)));

template <bool FULL>
__device__ __forceinline__ void ret_task(Frame& F, int row0, int nchunks, int head, const float* s_init_native, const float* s_init_de, float* s_out_native, float* s_out_de) {
    const int lane = F.lane, w = F.wave, q = lane >> 4, c15 = lane & 15;
    LAS unsigned char* L = F.lds;
    const bf16* Qg = (const bf16*)(F.ws + WS_Q); const bf16* Kg = (const bf16*)(F.ws + WS_K); const bf16* Vg = (const bf16*)(F.ws + WS_V); const bf16* SGg = (const bf16*)(F.ws + WS_SG);
    bf16* MIX = (bf16*)(F.ws + WS_MIX);
    const float lg2 = log2f(1.0f - exp2f(-5.0f - (float)head));
    const float dec = exp2f(lg2 * (float)(63 - lane)), g64 = exp2f(lg2 * 64.0f);
    f32x4 S[8];
    if (s_init_native) {
#pragma unroll
        for (int db = 0; db < 8; ++db) S[db] = *(const f32x4*)(s_init_native + ((size_t)(w * 8 + db) * 64 + lane) * 4);
    } else if (s_init_de) {
#pragma unroll
        for (int db = 0; db < 8; ++db)
#pragma unroll
            for (int r = 0; r < 4; ++r) S[db][r] = s_init_de[(size_t)(16 * db + 4 * q + r) * 128 + 16 * w + c15];
    } else {
#pragma unroll
        for (int db = 0; db < 8; ++db) S[db] = (f32x4){0.f, 0.f, 0.f, 0.f};
    }
    float cd[4]; f32x4 gw4 = (f32x4){0.f, 0.f, 0.f, 0.f};
    if (FULL) {
#pragma unroll
        for (int ib = 0; ib < 4; ++ib) cd[ib] = exp2f(lg2 * (float)(16 * ib + c15 + 1));
        gw4 = *(const f32x4*)(F.in[8] + 128 * head + 16 * w + 4 * q);
    }
    v4u pq[2], pk[2], pv[2];
#define RET_ISSUE(ch) do { _Pragma("unroll") for (int pi = 0; pi < 2; ++pi) { const size_t off = (size_t)(row0 + (ch) * 64 + lane) * 512 + 128 * head + 8 * (w + 8 * pi); \
        if (FULL) pq[pi] = *(const GAS v4u*)(Qg + off); pk[pi] = *(const GAS v4u*)(Kg + off); pv[pi] = *(const GAS v4u*)(Vg + off); } } while (0)
    RET_ISSUE(0);
    for (int ch = 0; ch < nchunks; ++ch) {
#pragma unroll
        for (int pi = 0; pi < 2; ++pi) { const int c = w + 8 * pi;
            if (FULL) { *(LAS v4u*)(L + QS + lane * QSTR + 16 * c) = pq[pi]; *(LAS v4u*)(L + KS + lane * QSTR + 16 * c) = pk[pi]; }
#pragma unroll
            for (int k = 0; k < 8; ++k) { *(LAS unsigned short*)(L + KT + (8 * c + k) * TSTR + 2 * lane) = (unsigned short)f2bf(bf2f(el16(pk[pi], k)) * dec);
                *(LAS unsigned short*)(L + VT + (8 * c + k) * TSTR + 2 * lane) = el16(pv[pi], k); } }
        if (ch + 1 < nchunks) RET_ISSUE(ch + 1);
        LDS_WAIT(); __builtin_amdgcn_s_barrier(); asm volatile("" ::: "memory");
        if (FULL) {
            const int mi = w >> 1;
#pragma unroll
            for (int t = 0; t < 2; ++t) { const int nj = 2 * (w & 1) + t; f32x4 a4 = (f32x4){0.f, 0.f, 0.f, 0.f};
#pragma unroll
                for (int s = 0; s < 4; ++s) { const bf16x8 a = *(const LAS bf16x8*)(L + KS + (16 * nj + c15) * QSTR + (32 * s + 8 * q) * 2), b = *(const LAS bf16x8*)(L + QS + (16 * mi + c15) * QSTR + (32 * s + 8 * q) * 2);
                    a4 = __builtin_amdgcn_mfma_f32_16x16x32_bf16(a, b, a4, 0, 0, 0); }
                const int i = 16 * mi + c15; float v[4];
#pragma unroll
                for (int r = 0; r < 4; ++r) { const int j = 16 * nj + 4 * q + r; v[r] = (i >= j) ? a4[r] * exp2f(lg2 * (float)(i - j)) : 0.f; }
                *(LAS u64*)(L + AS + i * TSTR + (16 * nj + 4 * q) * 2) = (u64)pk2(v[0], v[1]) | ((u64)pk2(v[2], v[3]) << 32); }
            LDS_WAIT(); __builtin_amdgcn_s_barrier(); asm volatile("" ::: "memory");
        }
        bf16x8 vt[2];
#pragma unroll
        for (int s = 0; s < 2; ++s) vt[s] = *(const LAS bf16x8*)(L + VT + (16 * w + c15) * TSTR + (32 * s + 8 * q) * 2);
        f32x4 acc[4];
        if (FULL) {
#pragma unroll
            for (int ib = 0; ib < 4; ++ib) acc[ib] = (f32x4){0.f, 0.f, 0.f, 0.f};
#pragma unroll
            for (int s = 0; s < 4; ++s) { v4u aw; aw.x = pk2(S[2 * s][0], S[2 * s][1]); aw.y = pk2(S[2 * s][2], S[2 * s][3]); aw.z = pk2(S[2 * s + 1][0], S[2 * s + 1][1]); aw.w = pk2(S[2 * s + 1][2], S[2 * s + 1][3]);
                const bf16x8 a = __builtin_bit_cast(bf16x8, aw);
#pragma unroll
                for (int ib = 0; ib < 4; ++ib) { const u64 lo = *(const LAS u64*)(L + QS + (16 * ib + c15) * QSTR + (32 * s + 4 * q) * 2), hi = *(const LAS u64*)(L + QS + (16 * ib + c15) * QSTR + (32 * s + 16 + 4 * q) * 2);
                    v4u bw; bw.x = (unsigned)lo; bw.y = (unsigned)(lo >> 32); bw.z = (unsigned)hi; bw.w = (unsigned)(hi >> 32);
                    acc[ib] = __builtin_amdgcn_mfma_f32_16x16x32_bf16(a, __builtin_bit_cast(bf16x8, bw), acc[ib], 0, 0, 0); } }
#pragma unroll
            for (int ib = 0; ib < 4; ++ib) acc[ib] = acc[ib] * cd[ib];
#pragma unroll
            for (int ib = 0; ib < 4; ++ib)
#pragma unroll
                for (int s = 0; s < 2; ++s) { if (s == 1 && ib < 2) continue;
                    const bf16x8 b = *(const LAS bf16x8*)(L + AS + (16 * ib + c15) * TSTR + (32 * s + 8 * q) * 2);
                    acc[ib] = __builtin_amdgcn_mfma_f32_16x16x32_bf16(vt[s], b, acc[ib], 0, 0, 0); }
        }
#pragma unroll
        for (int db = 0; db < 8; ++db) { S[db] = S[db] * g64;
#pragma unroll
            for (int s = 0; s < 2; ++s) { const bf16x8 a = *(const LAS bf16x8*)(L + KT + (16 * db + c15) * TSTR + (32 * s + 8 * q) * 2);
                S[db] = __builtin_amdgcn_mfma_f32_16x16x32_bf16(a, vt[s], S[db], 0, 0, 0); } }
        if (FULL) {
#pragma unroll
            for (int ib = 0; ib < 4; ++ib) { float s1 = (acc[ib][0] + acc[ib][1]) + (acc[ib][2] + acc[ib][3]); s1 += __shfl_xor(s1, 16); s1 += __shfl_xor(s1, 32);
                const float mw = s1 * (1.0f / 16.0f); const f32x4 dd = acc[ib] - mw; float m2 = (dd[0] * dd[0] + dd[1] * dd[1]) + (dd[2] * dd[2] + dd[3] * dd[3]); m2 += __shfl_xor(m2, 16); m2 += __shfl_xor(m2, 32);
                if (q == 0) *(LAS f32x2*)(L + ST + ((16 * ib + c15) * 8 + w) * 8) = (f32x2){mw, m2}; }
            LDS_WAIT(); __builtin_amdgcn_s_barrier(); asm volatile("" ::: "memory");
#pragma unroll
            for (int ib = 0; ib < 4; ++ib) { const int i = 16 * ib + c15; const LAS f32x4* sp = (const LAS f32x4*)(L + ST + i * 64);
                const f32x4 p0 = sp[0], p1 = sp[1], p2 = sp[2], p3 = sp[3];
                const float mean = ((p0[0] + p0[2]) + (p1[0] + p1[2]) + (p2[0] + p2[2]) + (p3[0] + p3[2])) * 0.125f;
                const float d0 = p0[0] - mean, d1 = p0[2] - mean, d2 = p1[0] - mean, d3 = p1[2] - mean, d4 = p2[0] - mean, d5 = p2[2] - mean, d6 = p3[0] - mean, d7 = p3[2] - mean;
                const float M2 = ((p0[1] + p0[3]) + (p1[1] + p1[3]) + (p2[1] + p2[3]) + (p3[1] + p3[3])) + 16.0f * ((d0 * d0 + d1 * d1) + (d2 * d2 + d3 * d3) + (d4 * d4 + d5 * d5) + (d6 * d6 + d7 * d7));
                const float rsd = 1.0f / sqrtf(M2 * (1.0f / 128.0f) + GN_EPS);
                const size_t row = (size_t)(row0 + ch * 64 + i); const int cc = 128 * head + 16 * w + 4 * q;
                const u64 sgw = *(const GAS u64*)(SGg + row * 512 + cc);
                const float o0 = (acc[ib][0] - mean) * rsd * gw4[0] * bf2f((unsigned short)(sgw & 0xffff)), o1 = (acc[ib][1] - mean) * rsd * gw4[1] * bf2f((unsigned short)((sgw >> 16) & 0xffff));
                const float o2 = (acc[ib][2] - mean) * rsd * gw4[2] * bf2f((unsigned short)((sgw >> 32) & 0xffff)), o3 = (acc[ib][3] - mean) * rsd * gw4[3] * bf2f((unsigned short)(sgw >> 48));
                *(GAS u64*)(MIX + row * DM + 512 + cc) = (u64)pk2(o0, o1) | ((u64)pk2(o2, o3) << 32); }
        } else {
            LDS_WAIT(); __builtin_amdgcn_s_barrier(); asm volatile("" ::: "memory");
        }
    }
#undef RET_ISSUE
    if (s_out_native) {
#pragma unroll
        for (int db = 0; db < 8; ++db) *(f32x4*)(s_out_native + ((size_t)(w * 8 + db) * 64 + lane) * 4) = S[db];
    }
    if (s_out_de) {
#pragma unroll
        for (int db = 0; db < 8; ++db)
#pragma unroll
            for (int r = 0; r < 4; ++r) s_out_de[(size_t)(16 * db + 4 * q + r) * 128 + 16 * w + c15] = S[db][r];
    }
    __syncthreads();
}
__device__ __forceinline__ void smeta_task(Frame& F, int head, float* out_native) {
    LAS float* km = (LAS float*)(F.lds); LAS float* vm = km + 2048;
    const float* MPJ = (const float*)(F.ws + WS_META); const float* ROPE = (const float*)(F.ws + WS_ROPE);
    const float lg2 = log2f(1.0f - exp2f(-5.0f - (float)head));
    __syncthreads();
    for (int idx = F.tid; idx < 2048; idx += 512) { const int j = idx >> 7, d = idx & 127, i = d & 63, ap = 16 - j;
        const float x1 = MPJ[(size_t)j * DIN + mcol_k(head, i)], x2 = MPJ[(size_t)j * DIN + mcol_k(head, 64 + i)];
        const float c = ROPE[2 * (ap * 64 + i)], s = -ROPE[2 * (ap * 64 + i) + 1];
        km[idx] = ((d < 64) ? (x1 * c - x2 * s) : (x1 * s + x2 * c)) * exp2f(lg2 * (float)(15 - j));
        vm[idx] = MPJ[(size_t)j * DIN + mcol_v(head, d)]; }
    LDS_WAIT(); __syncthreads();
    const int lane = F.lane, w = F.wave, q = lane >> 4, c15 = lane & 15;
    for (int db = 0; db < 8; ++db) { f32x4 o;
#pragma unroll
        for (int r = 0; r < 4; ++r) { const int d = 16 * db + 4 * q + r, e = 16 * w + c15; float a = 0.f;
            for (int j = 0; j < 16; ++j) a += km[j * 128 + d] * vm[j * 128 + e];
            o[r] = a; }
        *(f32x4*)(out_native + ((size_t)(w * 8 + db) * 64 + lane) * 4) = o; }
    __syncthreads();
}
}
#if RET_ORACLE
__device__ __forceinline__ void ret_oracle_task(Frame& F, int stream, int head, bf16* MIXO, float* retp, float* rets) {
    LAS float* S = (LAS float*)(F.lds);
    LAS bf16* qs = (LAS bf16*)(F.lds + 65536); LAS bf16* ks = (LAS bf16*)(F.lds + 81920); LAS bf16* vs = (LAS bf16*)(F.lds + 98304);
    LAS float* sc = (LAS float*)(F.lds + 114688);
    const bf16* Q = (const bf16*)(F.ws + WS_Q); const bf16* Kb = (const bf16*)(F.ws + WS_K); const bf16* V = (const bf16*)(F.ws + WS_V); const bf16* SG = (const bf16*)(F.ws + WS_SG);
    const float* MPJ = (const float*)(F.ws + WS_META); const float* ROPE = (const float*)(F.ws + WS_ROPE); const float* gnw = F.in[8];
    const float lg = logf(1.0f - exp2f(-5.0f - (float)head));
    const bool pr = stream < NBP; const int tid = F.tid;
    __syncthreads();
    if (pr) {
        LAS float* km = sc; LAS float* vm = sc + 2048;
        for (int idx = tid; idx < 2048; idx += 512) { const int j = idx >> 7, d = idx & 127, i = d & 63, ap = 16 - j;
            const float x1 = MPJ[(size_t)j * DIN + mcol_k(head, i)], x2 = MPJ[(size_t)j * DIN + mcol_k(head, 64 + i)];
            const float c = ROPE[2 * (ap * 64 + i)], s = -ROPE[2 * (ap * 64 + i) + 1];
            km[idx] = (d < 64) ? (x1 * c - x2 * s) : (x1 * s + x2 * c);
            vm[idx] = MPJ[(size_t)j * DIN + mcol_v(head, d)]; }
        LDS_WAIT(); __syncthreads();
        for (int idx = tid; idx < 16384; idx += 512) { const int d = idx >> 7, e = idx & 127; float a = 0.f;
            for (int j = 0; j < 16; ++j) a += km[j * 128 + d] * __expf(lg * (float)(15 - j)) * vm[j * 128 + e];
            S[idx] = a; }
    } else {
        const float* sr = F.in[3] + ((size_t)(stream - NBP) * NH + head) * DH * DH;
        for (int idx = tid; idx < 16384; idx += 512) S[idx] = sr[idx];
    }
    LDS_WAIT(); __syncthreads();
    const int nchunk = pr ? SEQ / 64 : 1;
    for (int ch = 0; ch < nchunk; ++ch) {
        const int row0 = pr ? stream * SEQ + ch * 64 : MP + (stream - NBP) * 64;
        for (int x = tid; x < 1024; x += 512) { const int i = x >> 4, c8 = (x & 15) * 8; const size_t g = (size_t)(row0 + i) * 512 + head * 128 + c8;
            *(LAS v4u*)(qs + i * 128 + c8) = *(const GAS v4u*)(Q + g); *(LAS v4u*)(ks + i * 128 + c8) = *(const GAS v4u*)(Kb + g); *(LAS v4u*)(vs + i * 128 + c8) = *(const GAS v4u*)(V + g); }
        LDS_WAIT(); __syncthreads();
        { const int i = tid >> 3, jg = tid & 7;
            for (int jj = 0; jj < 8; ++jj) { const int j = 8 * jg + jj; float a = 0.f;
                if (j <= i) { for (int d = 0; d < 128; ++d) a += bf2f(qs[i * 128 + d]) * bf2f(ks[j * 128 + d]); a *= __expf(lg * (float)(i - j)); }
                sc[i * 64 + j] = a; } }
        LDS_WAIT(); __syncthreads();
        { const int i = tid >> 3, eg = tid & 7, e0 = 16 * eg; float acc[16];
#pragma unroll
            for (int e = 0; e < 16; ++e) acc[e] = 0.f;
            for (int j = 0; j <= i; ++j) { const float s = sc[i * 64 + j];
#pragma unroll
                for (int e = 0; e < 16; ++e) acc[e] += s * bf2f(vs[j * 128 + e0 + e]); }
            const float cd = __expf(lg * (float)(i + 1));
            for (int d = 0; d < 128; ++d) { const float qd = bf2f(qs[i * 128 + d]) * cd;
#pragma unroll
                for (int e = 0; e < 16; ++e) acc[e] += qd * S[d * 128 + e0 + e]; }
            float sum = 0.f;
#pragma unroll
            for (int e = 0; e < 16; ++e) sum += acc[e];
            sum += __shfl_xor(sum, 1); sum += __shfl_xor(sum, 2); sum += __shfl_xor(sum, 4);
            const float mu = sum * (1.0f / 128.0f); float var = 0.f;
#pragma unroll
            for (int e = 0; e < 16; ++e) { const float dd = acc[e] - mu; var += dd * dd; }
            var += __shfl_xor(var, 1); var += __shfl_xor(var, 2); var += __shfl_xor(var, 4);
            const float rsd = 1.0f / sqrtf(var * (1.0f / 128.0f) + GN_EPS);
            const size_t r = (size_t)(row0 + i);
#pragma unroll
            for (int e = 0; e < 16; e += 2) { const int cc = head * 128 + e0 + e;
                const float o0 = (acc[e] - mu) * rsd * gnw[cc] * bf2f(SG[r * 512 + cc]), o1 = (acc[e + 1] - mu) * rsd * gnw[cc + 1] * bf2f(SG[r * 512 + cc + 1]);
                *(GAS unsigned*)(MIXO + r * DM + 512 + cc) = pk2(o0, o1); } }
        __syncthreads();
        { const int d = tid >> 2, e0 = 32 * (tid & 3); float acc[32]; const float g64 = __expf(lg * 64.0f);
#pragma unroll
            for (int e = 0; e < 32; ++e) acc[e] = g64 * S[d * 128 + e0 + e];
            for (int j = 0; j < 64; ++j) { const float kd = bf2f(ks[j * 128 + d]) * __expf(lg * (float)(63 - j));
#pragma unroll
                for (int e = 0; e < 32; ++e) acc[e] += kd * bf2f(vs[j * 128 + e0 + e]); }
#pragma unroll
            for (int e = 0; e < 32; ++e) S[d * 128 + e0 + e] = acc[e]; }
        LDS_WAIT(); __syncthreads();
    }
    float* dst = pr ? retp + ((size_t)stream * NH + head) * DH * DH : rets + ((size_t)(stream - NBP) * NH + head) * DH * DH;
    for (int idx = tid; idx < 16384; idx += 512) dst[idx] = S[idx];
    __syncthreads();
}

#endif
__device__ __forceinline__ void scan_phase(Frame& F) {
    const f32x4* TG = (const f32x4*)(F.ws + WS_TG); f32x4* GG = (f32x4*)(F.ws + WS_GG); const f32x4* SM = (const f32x4*)(F.ws + WS_SMETA);
    const int nthr = F.G * NWAVES * 64;
    for (int x = F.vcu * NWAVES * 64 + F.tid; x < 16 * 4096; x += nthr) { const int bh = x >> 12, f4 = x & 4095, h = bh & 3;
        const float g512 = exp2f(log2f(1.0f - exp2f(-5.0f - (float)h)) * 512.0f);
        f32x4 t[16];
#pragma unroll
        for (int g = 0; g < 16; ++g) t[g] = TG[(size_t)(bh * 16 + g) * 4096 + f4];
        f32x4 G = SM[(size_t)h * 4096 + f4];
#pragma unroll
        for (int g = 0; g < 16; ++g) { GG[(size_t)(bh * 16 + g) * 4096 + f4] = G; G = G * g512 + t[g]; } }
}
__device__ __forceinline__ void final_norm(Frame& F) {
    const float* ssq = (const float*)(F.ws + WS_SSQ2); const float* wf = F.in[13];
    const int gw = F.vcu * NWAVES + F.wave, NGW = F.G * NWAVES;
    f32x4 wv[4];
#pragma unroll
    for (int j = 0; j < 4; ++j) wv[j] = *(const f32x4*)(wf + 4 * (F.lane + 64 * j));
    for (int m = gw; m < M; m += NGW) {
        float s = (F.lane < 16) ? ssq[(size_t)m * 16 + F.lane] : 0.f; s = wave_sum(s);
        const float rs = 1.0f / sqrtf(s * (1.0f / DM) + NORM_EPS);
        GAS f32x4* p = (GAS f32x4*)(F.out + (size_t)m * DM) + F.lane;
#pragma unroll
        for (int j = 0; j < 4; ++j) { const f32x4 v = p[64 * j]; p[64 * j] = v * rs * wv[j]; }
    }
}

constexpr int N_PHASES = 9;
struct Args { const float* in[14]; float* out; unsigned char* ws; int ph_lo, ph_hi; };
static_assert(sizeof(Args) == 14 * 8 + 8 + 8 + 8, "Args has no padding");
__global__ void __launch_bounds__(NWAVES * 64, 2) mk_fwd(Args args) {
    extern __shared__ __attribute__((aligned(16))) unsigned char lds[];
    Frame F;
    F.lds = (LAS unsigned char*)lds;
    F.MISC = (volatile LAS unsigned*)(F.lds + MISC_OFF);
    F.tid = threadIdx.x; F.lane = F.tid & 63; F.wave = __builtin_amdgcn_readfirstlane(F.tid >> 6);
    F.G = gridDim.x; { const int bx = blockIdx.x; F.vcu = (F.G % 8 == 0) ? (bx % 8) * (F.G / 8) + bx / 8 : bx; }
    F.ws = args.ws; F.out = args.out; F.ctl = (gu32*)(args.ws + WS_CTL);
#pragma unroll
    for (int i = 0; i < 14; ++i) F.in[i] = args.in[i];
    for (int u = F.tid; u < (LDS_BYTES - LDSCTL_OFF) / 4; u += NWAVES * 64) ((LAS unsigned*)(F.lds + LDSCTL_OFF))[u] = 0u;
    __syncthreads();
    const int lo = args.ph_lo, hi = args.ph_hi;
    const bool one_launch = (lo == 0 && hi == N_PHASES);
    XcdBarrier bar; bar.bar = (unsigned*)(F.ctl + CW_BAR); bar.x = 0; bar.st = nullptr;
    if (one_launch) bar = xcd_barrier_post((unsigned*)(F.ctl + CW_BAR), F.MISC + 8);
#define IN(k) (lo <= (k) && (k) < hi)
#define SEAM(k) do { if (IN(k) && IN((k) + 1)) xcd_barrier(bar); } while (0)

    if (IN(0)) { p0_prologue(F); } SEAM(0);
    if (IN(1)) {
        pg8::Gemm g{(const pg8::bf16_t*)(F.ws + WS_XB), (const pg8::bf16_t*)(F.ws + WS_WIN), M, DIN, DM}; pg8::StaticOrder S; S.init(M, DIN, F.G, (int)blockIdx.x);
        pg8::EpiIn E{(pg8::bf16_t*)(F.ws + WS_U), (const float*)(F.ws + WS_RSTD1), (const float*)(F.ws + WS_ROPE)};
        pg8::gemm_phase<pg8::EpiIn, pg8::StaticOrder, true, true>(F.lds + RING_OFF, g, S, E);
        meta_proj(F);
    } SEAM(1);
    if (IN(2)) {
        conv_phase(F);
        for (int t = blockIdx.x; t < 260; t += F.G) {
            if (t < 256) { const int bh = t >> 4, g = t & 15; ret::ret_task<false>(F, (bh >> 2) * SEQ + g * 512, 8, bh & 3, nullptr, nullptr, (float*)(F.ws + WS_TG) + (size_t)t * 16384, nullptr); }
            else ret::smeta_task(F, t - 256, (float*)(F.ws + WS_SMETA) + (size_t)(t - 256) * 16384);
        }
    } SEAM(2);
    if (IN(3)) { scan_phase(F); } SEAM(3);
    if (IN(4)) {
        for (int t = blockIdx.x; t < 384; t += F.G) {
            int row0, nch, head; const float* sn = nullptr; const float* sd = nullptr; float* od = nullptr;
            if (t < 256) { const int bh = t >> 4, g = t & 15; row0 = (bh >> 2) * SEQ + g * 512; nch = 8; head = bh & 3; sn = (const float*)(F.ws + WS_GG) + (size_t)t * 16384; if (g == 15) od = F.out + O_RETP + (size_t)bh * 16384; }
            else { const int sh = t - 256; row0 = MP + (sh >> 2) * 64; nch = 1; head = sh & 3; sd = F.in[3] + (size_t)sh * 16384; od = F.out + O_RETS + (size_t)sh * 16384; }
            ret::ret_task<true>(F, row0, nch, head, sn, sd, nullptr, od);
        }
#if RET_ORACLE

#endif
    } SEAM(4);
    if (IN(5)) {
        pg8::Gemm g{(const pg8::bf16_t*)(F.ws + WS_MIX), (const pg8::bf16_t*)(F.ws + WS_WOUT), M, DM, DM}; pg8::StaticOrder S; S.init(M, DM, F.G, (int)blockIdx.x);
        pg8::EpiOut E{F.in[0], F.in[1], F.out + O_Y, (pg8::bf16_t*)(F.ws + WS_XB), (float*)(F.ws + WS_SSQ1)};
        pg8::gemm_phase<pg8::EpiOut, pg8::StaticOrder, true, true>(F.lds + RING_OFF, g, S, E);
    } SEAM(5);
    if (IN(6)) {
        pg8::Gemm g{(const pg8::bf16_t*)(F.ws + WS_XB), (const pg8::bf16_t*)(F.ws + WS_WUP), M, DFF, DM}; pg8::StaticOrder S; S.init(M, DFF, F.G, (int)blockIdx.x);
        pg8::EpiUp E{(pg8::bf16_t*)(F.ws + WS_ACT), (const float*)(F.ws + WS_SSQ1), NORM_EPS};
        pg8::gemm_phase<pg8::EpiUp, pg8::StaticOrder, true, true>(F.lds + RING_OFF, g, S, E);
    } SEAM(6);
    if (IN(7)) {
        pg8::Gemm g{(const pg8::bf16_t*)(F.ws + WS_ACT), (const pg8::bf16_t*)(F.ws + WS_WDN), M, DM, DFF}; pg8::StaticOrder S; S.init(M, DM, F.G, (int)blockIdx.x);
        pg8::EpiDown E{F.out + O_Y, (float*)(F.ws + WS_SSQ2)};
        pg8::gemm_phase<pg8::EpiDown, pg8::StaticOrder, true, true>(F.lds + RING_OFF, g, S, E);
    } SEAM(7);
    if (IN(8)) { final_norm(F); }
#undef IN
#undef SEAM
}

#ifndef MK_ONE_LAUNCH
#define MK_ONE_LAUNCH 1
#endif
extern "C" void kernel_launch(void* const* d_in, const int* in_sizes, int n_in, void* d_out, int out_size, void* d_ws, size_t ws_size, hipStream_t stream) {
    static int grid = 0;
    if (grid == 0) {
        if (n_in != 14 || in_sizes[0] != MP * DM || in_sizes[1] != MS * DM || (size_t)out_size != O_END || ws_size < WS_END) {
            fprintf(stderr, "kernel_launch: unexpected shapes: n_in %d in0 %d in1 %d out %d ws %zu (need %zu); nothing launched\n", n_in, n_in > 0 ? in_sizes[0] : -1, n_in > 1 ? in_sizes[1] : -1, out_size, ws_size, (size_t)WS_END); grid = -1; return; }
        int dev = 0, cus = 0;
        if (hipGetDevice(&dev) != hipSuccess || hipDeviceGetAttribute(&cus, hipDeviceAttributeMultiprocessorCount, dev) != hipSuccess) { fprintf(stderr, "kernel_launch: device query failed\n"); grid = -1; return; }
        if (hipFuncSetAttribute((const void*)mk_fwd, hipFuncAttributeMaxDynamicSharedMemorySize, LDS_BYTES) != hipSuccess) { fprintf(stderr, "kernel_launch: hipFuncSetAttribute failed\n"); grid = -1; return; }
        int per_cu = 0;
        if (hipOccupancyMaxActiveBlocksPerMultiprocessor(&per_cu, (const void*)mk_fwd, NWAVES * 64, LDS_BYTES) != hipSuccess || per_cu < 1) fprintf(stderr, "kernel_launch: occupancy query says %d per CU\n", per_cu);
        (void)hipGetLastError();
        grid = cus;
    }
    if (grid < 0) return;
    if (hipMemsetAsync((char*)d_ws + WS_CTL, 0, CTL_ZERO_BYTES, stream) != hipSuccess) { fprintf(stderr, "kernel_launch: memset failed\n"); return; }
    Args a{};
    for (int i = 0; i < 14; ++i) a.in[i] = (const float*)d_in[i];
    a.out = (float*)d_out; a.ws = (unsigned char*)d_ws;
#if MK_ONE_LAUNCH
    a.ph_lo = 0; a.ph_hi = N_PHASES;
    hipLaunchKernelGGL(mk_fwd, dim3(grid), dim3(NWAVES * 64), LDS_BYTES, stream, a);
#else
    for (int p = 0; p < N_PHASES; ++p) { a.ph_lo = p; a.ph_hi = p + 1; hipLaunchKernelGGL(mk_fwd, dim3(grid), dim3(NWAVES * 64), LDS_BYTES, stream, a); }
#endif
    const hipError_t le = hipPeekAtLastError();
    if (le != hipSuccess) fprintf(stderr, "kernel_launch: launch failed: %s\n", hipGetErrorName(le));
}
```

```cpp
#include <hip/hip_runtime.h>
#include <cstdio>
#include <cstdint>
#ifndef RET_ORACLE
#define RET_ORACLE 0
#endif
namespace pg8 {
#define PG8_LAS __attribute__((address_space(3)))
typedef unsigned short bf16_t;
typedef short bf16x8 __attribute__((ext_vector_type(8)));
typedef float f32x4 __attribute__((ext_vector_type(4)));
typedef unsigned u32x4 __attribute__((ext_vector_type(4)));
constexpr int BM = 256, BK = 64, HALF = 128, HTB = HALF * BK * 2  , STAGE_BYTES = 8 * HTB, NXCD = 8, WGM = 8;

__host__ __device__ __forceinline__ int lds_byte(int r, int c) { const int st = (r >> 4) * 2 + (c >> 5), rr = r & 15, cc = c & 31, ob = rr * 64 + cc * 2; return st * 1024 + (ob ^ (((ob >> 9) & 1) << 5)); }
__host__ __device__ __forceinline__ void stage_rc(int b, int& R, int& C) { const int st = b / 1024, sb = b % 1024, swz = sb ^ (((sb >> 9) & 1) << 5); R = (st >> 1) * 16 + swz / 64; C = (st & 1) * 32 + (swz % 64) / 2; }
__host__ __device__ __forceinline__ int perm32(int rho) { const int n = rho >> 4, i = rho & 15; return 8 * (i >> 2) + 4 * n + (i & 3); }

struct Unit { int pm, pn, kt0, ntu, kind; };
struct Gemm { const bf16_t* A; const bf16_t* Bt; int M, N, K; };

struct StaticOrder {
    int nM, nN, nwg, G, c, ntk;
    __host__ __device__ void init(int M, int N, int G_, int c_, int ntk_) { nM = M / BM; nN = N / BM; nwg = nM * nN; G = G_; c = c_; ntk = ntk_; }
    __host__ __device__ bool next(int i, Unit& u) const {
        const long L = (long)i * G + c; if (L >= nwg) return false;
        int wgid = (int)L; { const int q = nwg / NXCD, r = nwg % NXCD, xcd = wgid % NXCD, off = wgid / NXCD; wgid = (xcd < r ? xcd * (q + 1) : r * (q + 1) + (xcd - r) * q) + off; }
        const int nig = WGM * nN, gid = wgid / nig, fm = gid * WGM, gsz = (nM - fm) < WGM ? (nM - fm) : WGM;
        u.pm = fm + ((wgid % nig) % gsz); u.pn = (wgid % nig) / gsz; u.kt0 = 0; u.ntu = ntk; u.kind = 0; return true;
    }
    __device__ __forceinline__ void a_ready(const Unit&) const {}
    __device__ __forceinline__ void done(const Unit&) const {}
};
struct SplitOrder {
    StaticOrder so; int c, ntk; bool split;
    __host__ __device__ void init(int M, int Mfull, int N, int G_, int c_, int ntk_) { split = (G_ == 256 && N == 4 * BM && (M - Mfull) == 8 * BM && ntk_ % 16 == 0); so.init(split ? Mfull : M, N, G_, c_, ntk_); c = c_; ntk = ntk_; }
    __host__ __device__ bool next(int i, Unit& u) const {
        const bool piece = split && i >= 2; Unit t; const bool ok = so.next(piece ? 0 : i, t);
        const int kp = c & 7, idx = c >> 3, pl = ntk / 8;
        u.pm = piece ? so.nM + (idx & 7) : t.pm; u.pn = piece ? (idx >> 3) : t.pn; u.kt0 = piece ? kp * pl : 0; u.ntu = piece ? pl : ntk; u.kind = piece ? 1 : 0;
        return piece ? (i == 2) : ok;
    }
    __device__ __forceinline__ void a_ready(const Unit&) const {}
    __device__ __forceinline__ void done(const Unit&) const {}
};

__device__ __forceinline__ unsigned cvt_pk_bf16(float lo, float hi) { unsigned r; asm volatile("v_cvt_pk_bf16_f32 %0, %1, %2" : "=v"(r) : "v"(lo), "v"(hi)); return r; }
typedef float f32x2 __attribute__((ext_vector_type(2)));
typedef float f32x2v __attribute__((ext_vector_type(2)));
typedef unsigned u32x2 __attribute__((ext_vector_type(2)));
constexpr int ROWS_P = 32768;
__device__ __forceinline__ int row_pos(int r) { return r < ROWS_P ? (r & 8191) : 2048 + (r & 63); }
__device__ __forceinline__ float silu_f(float x) { return x * __builtin_amdgcn_rcpf(1.0f + __builtin_amdgcn_exp2f(-1.4426950408889634f * x)); }

struct EpiIn {
    static constexpr bool PERM = true, AFTER_DRAIN = false;
    bf16_t* base; const float* rstd; const float* rope;
    static constexpr size_t REG = (size_t)34816 * 512;
    __device__ __forceinline__ void operator()(const f32x4 (&acc)[2][2][4][2], const Unit& u, int wr, int wc, int fr, int fq) const {
        const int pn = u.pn, lc0 = wc * 32 + 8 * fq;
        const int rbase = u.pm * BM + wr * 64 + fr;
        if (pn < 4) {
#pragma unroll
            for (int ai = 0; ai < 2; ++ai)
#pragma unroll
                for (int m = 0; m < 4; ++m) { const int r = rbase + ai * HALF + m * 16; const float rs = rstd[r], rs2 = rs * rs;
                    const f32x4 a0 = acc[ai][0][m][0] * acc[ai][1][m][0] * rs2, a1 = acc[ai][0][m][1] * acc[ai][1][m][1] * rs2;
                    u32x4 w; w.x = cvt_pk_bf16(a0[0], a0[1]); w.y = cvt_pk_bf16(a0[2], a0[3]); w.z = cvt_pk_bf16(a1[0], a1[1]); w.w = cvt_pk_bf16(a1[2], a1[3]);
                    *(u32x4*)(base + (size_t)r * 512 + pn * 128 + lc0) = w; }
        } else if (pn >= 6 && pn < 10) {
            bf16_t* dst = base + (size_t)(2 + ((pn - 6) >> 1)) * REG; const int head = 2 * ((pn - 6) & 1) + (lc0 >> 6), i0 = lc0 & 63;
#pragma unroll
            for (int ai = 0; ai < 2; ++ai)
#pragma unroll
                for (int m = 0; m < 4; ++m) { const int r = rbase + ai * HALF + m * 16; const float rs = rstd[r];
                    const f32x4* cs = (const f32x4*)(rope + ((size_t)row_pos(r) * 64 + i0) * 2);
                    const f32x4 c0 = cs[0], c1 = cs[1], c2 = cs[2], c3 = cs[3];
                    const f32x4 x1a = acc[ai][0][m][0] * rs, x1b = acc[ai][0][m][1] * rs, x2a = acc[ai][1][m][0] * rs, x2b = acc[ai][1][m][1] * rs;
                    float o1[8], o2[8];
                    o1[0] = x1a[0] * c0[0] - x2a[0] * c0[1]; o2[0] = x1a[0] * c0[1] + x2a[0] * c0[0];
                    o1[1] = x1a[1] * c0[2] - x2a[1] * c0[3]; o2[1] = x1a[1] * c0[3] + x2a[1] * c0[2];
                    o1[2] = x1a[2] * c1[0] - x2a[2] * c1[1]; o2[2] = x1a[2] * c1[1] + x2a[2] * c1[0];
                    o1[3] = x1a[3] * c1[2] - x2a[3] * c1[3]; o2[3] = x1a[3] * c1[3] + x2a[3] * c1[2];
                    o1[4] = x1b[0] * c2[0] - x2b[0] * c2[1]; o2[4] = x1b[0] * c2[1] + x2b[0] * c2[0];
                    o1[5] = x1b[1] * c2[2] - x2b[1] * c2[3]; o2[5] = x1b[1] * c2[3] + x2b[1] * c2[2];
                    o1[6] = x1b[2] * c3[0] - x2b[2] * c3[1]; o2[6] = x1b[2] * c3[1] + x2b[2] * c3[0];
                    o1[7] = x1b[3] * c3[2] - x2b[3] * c3[3]; o2[7] = x1b[3] * c3[3] + x2b[3] * c3[2];
                    u32x4 w1, w2; w1.x = cvt_pk_bf16(o1[0], o1[1]); w1.y = cvt_pk_bf16(o1[2], o1[3]); w1.z = cvt_pk_bf16(o1[4], o1[5]); w1.w = cvt_pk_bf16(o1[6], o1[7]);
                    w2.x = cvt_pk_bf16(o2[0], o2[1]); w2.y = cvt_pk_bf16(o2[2], o2[3]); w2.z = cvt_pk_bf16(o2[4], o2[5]); w2.w = cvt_pk_bf16(o2[6], o2[7]);
                    bf16_t* p = dst + (size_t)r * 512 + head * 128 + i0;
                    *(u32x4*)p = w1; *(u32x4*)(p + 64) = w2; }
        } else {
            const int reg = (pn < 6) ? 1 : (pn < 12 ? 4 : 5); bf16_t* dst = base + (size_t)reg * REG; const int cb = (pn & 1) * 256; const bool act = pn >= 12;
#pragma unroll
            for (int ai = 0; ai < 2; ++ai)
#pragma unroll
                for (int m = 0; m < 4; ++m) { const int r = rbase + ai * HALF + m * 16; const float rs = rstd[r];
#pragma unroll
                    for (int bj = 0; bj < 2; ++bj) { f32x4 v0 = acc[ai][bj][m][0] * rs, v1 = acc[ai][bj][m][1] * rs;
                        if (act) { v0 = (f32x4){silu_f(v0[0]), silu_f(v0[1]), silu_f(v0[2]), silu_f(v0[3])}; v1 = (f32x4){silu_f(v1[0]), silu_f(v1[1]), silu_f(v1[2]), silu_f(v1[3])}; }
                        u32x4 w; w.x = cvt_pk_bf16(v0[0], v0[1]); w.y = cvt_pk_bf16(v0[2], v0[3]); w.z = cvt_pk_bf16(v1[0], v1[1]); w.w = cvt_pk_bf16(v1[2], v1[3]);
                        *(u32x4*)(dst + (size_t)r * 512 + cb + bj * HALF + lc0) = w; } }
        }
    }
};

struct EpiOut {
    static constexpr bool PERM = false, AFTER_DRAIN = false;
    const float* xp; const float* xs; float* out; bf16_t* Hb; float* ssq;
    __device__ __forceinline__ void operator()(const f32x4 (&acc)[2][2][4][2], const Unit& u, int wr, int wc, int fr, int fq) const {
        const int rbase = u.pm * BM + wr * 64 + fr, col0 = u.pn * BM + wc * 32 + 4 * fq;
#pragma unroll
        for (int ai = 0; ai < 2; ++ai)
#pragma unroll
            for (int m = 0; m < 4; ++m) { const int r = rbase + ai * HALF + m * 16;
                const float* xrow = (r < ROWS_P) ? xp + (size_t)r * 1024 : xs + (size_t)(r - ROWS_P) * 1024;
                float s = 0.f;
#pragma unroll
                for (int bj = 0; bj < 2; ++bj)
#pragma unroll
                    for (int n = 0; n < 2; ++n) { const int c = col0 + bj * HALF + n * 16; const f32x4 h = *(const f32x4*)(xrow + c) + acc[ai][bj][m][n];
                        *(f32x4*)(out + (size_t)r * 1024 + c) = h; u32x2 w; w.x = cvt_pk_bf16(h[0], h[1]); w.y = cvt_pk_bf16(h[2], h[3]);
                        *(u32x2*)(Hb + (size_t)r * 1024 + c) = w; s += (h[0] * h[0] + h[1] * h[1]) + (h[2] * h[2] + h[3] * h[3]); }
                s += __shfl_xor(s, 16); s += __shfl_xor(s, 32);
                if (fq == 0) ssq[(size_t)r * 16 + u.pn * 4 + wc] = s; }
    }
};

struct EpiUp {
    static constexpr bool PERM = true, AFTER_DRAIN = false;
    bf16_t* ACT; const float* ssq; float eps;
    __device__ __forceinline__ void operator()(const f32x4 (&acc)[2][2][4][2], const Unit& u, int wr, int wc, int fr, int fq) const {
        const int rbase = u.pm * BM + wr * 64 + fr, col0 = u.pn * BM + wc * 32 + 8 * fq;
#pragma unroll
        for (int ai = 0; ai < 2; ++ai)
#pragma unroll
            for (int m = 0; m < 4; ++m) { const int r = rbase + ai * HALF + m * 16;
                const f32x4 p = *(const f32x4*)(ssq + (size_t)r * 16 + 4 * fq); float s = (p[0] + p[1]) + (p[2] + p[3]);
                s += __shfl_xor(s, 16); s += __shfl_xor(s, 32);
                const float rs = __builtin_amdgcn_rsqf(s * (1.0f / 1024.0f) + eps);
#pragma unroll
                for (int bj = 0; bj < 2; ++bj) { f32x4 v0 = acc[ai][bj][m][0] * rs, v1 = acc[ai][bj][m][1] * rs;
#pragma unroll
                    for (int j = 0; j < 4; ++j) { const float a = fmaxf(v0[j], 0.f), b = fmaxf(v1[j], 0.f); v0[j] = a * a; v1[j] = b * b; }
                    u32x4 w; w.x = cvt_pk_bf16(v0[0], v0[1]); w.y = cvt_pk_bf16(v0[2], v0[3]); w.z = cvt_pk_bf16(v1[0], v1[1]); w.w = cvt_pk_bf16(v1[2], v1[3]);
                    *(u32x4*)(ACT + (size_t)r * 4096 + col0 + bj * HALF) = w; } }
    }
};

struct EpiDown {
    static constexpr bool PERM = false, AFTER_DRAIN = false;
    float* out; float* part;
    __device__ __forceinline__ void operator()(const f32x4 (&acc)[2][2][4][2], const Unit& u, int wr, int wc, int fr, int fq) const {
        const int rbase = u.pm * BM + wr * 64 + fr, col0 = u.pn * BM + wc * 32 + 4 * fq;
        if (u.kind == 0) {
#pragma unroll
            for (int ai = 0; ai < 2; ++ai)
#pragma unroll
                for (int m = 0; m < 4; ++m) { const int r = rbase + ai * HALF + m * 16;
#pragma unroll
                    for (int bj = 0; bj < 2; ++bj)
#pragma unroll
                        for (int n = 0; n < 2; ++n) { float* p = out + (size_t)r * 1024 + col0 + bj * HALF + n * 16; *(f32x4*)p = *(const f32x4*)p + acc[ai][bj][m][n]; } }
        } else {
            float* pb = part + (size_t)(u.kt0 / u.ntu) * (2048 * 1024);
#pragma unroll
            for (int ai = 0; ai < 2; ++ai)
#pragma unroll
                for (int m = 0; m < 4; ++m) { const int r = rbase + ai * HALF + m * 16 - ROWS_P;
#pragma unroll
                    for (int bj = 0; bj < 2; ++bj)
#pragma unroll
                        for (int n = 0; n < 2; ++n) *(f32x4*)(pb + (size_t)r * 1024 + col0 + bj * HALF + n * 16) = acc[ai][bj][m][n]; }
        }
    }
};
template <class Epi, class Sched, bool ALIGN_EPI = false, bool SP2 = false>
__device__ __forceinline__ void gemm_phase(PG8_LAS unsigned char* lds, const Gemm g, const Sched& S, const Epi& E) {
    const int tid = threadIdx.x, wid = __builtin_amdgcn_readfirstlane(tid >> 6), lane = tid & 63, wr = wid >> 2, wc = wid & 3, fr = lane & 15, fq = lane >> 4;
    const int K = g.K;
    unsigned voffA[2], voffB[2];
#pragma unroll
    for (int i = 0; i < 2; ++i) { int R, C; stage_rc(tid * 16 + i * 8192, R, C); const int Rb = Epi::PERM ? ((R & ~31) + perm32(R & 31)) : R;
        voffA[i] = (unsigned)(R * K + C) * 2u; voffB[i] = (unsigned)(Rb * K + C) * 2u; }
    const size_t kstep = (size_t)(BK * 2);
    const size_t hstep = (size_t)HALF * K * 2;
    const size_t tstep = 2 * hstep;
    const unsigned ldsw = (unsigned)wid * 1024u;
    const int aoff = lds_byte(wr * 64 + fr, fq * 8), boff = lds_byte(wc * 32 + fr, fq * 8);
#define PG8_SA(b, h) (((b) * 2 + (h)) * HTB)
#define PG8_SB(b, h) ((4 + (b) * 2 + (h)) * HTB)
#define PG8_STAGE(bufoff, gbase, voff) do { _Pragma("unroll") for (int _i = 0; _i < 2; ++_i) \
        __builtin_amdgcn_global_load_lds((const unsigned*)((const char*)(gbase) + (voff)[_i]), (PG8_LAS unsigned*)(lds + (bufoff) + ldsw + _i * 8192), 16, 0, 0); } while (0)
#define PG8_LDA(dst, b, h) do { _Pragma("unroll") for (int m = 0; m < 4; ++m) _Pragma("unroll") for (int k = 0; k < 2; ++k) dst[m][k] = *(const PG8_LAS bf16x8*)(lds + PG8_SA(b, h) + aoff + m * 2048 + k * 1024); } while (0)
#define PG8_LDB(dst, b, h) do { _Pragma("unroll") for (int n = 0; n < 2; ++n) _Pragma("unroll") for (int k = 0; k < 2; ++k) dst[n][k] = *(const PG8_LAS bf16x8*)(lds + PG8_SB(b, h) + boff + n * 2048 + k * 1024); } while (0)
#define PG8_MMA(ai, bj, At, Bt) do { __builtin_amdgcn_s_setprio(1); _Pragma("unroll") for (int m = 0; m < 4; ++m) _Pragma("unroll") for (int n = 0; n < 2; ++n) _Pragma("unroll") for (int k = 0; k < 2; ++k) \
        acc[ai][bj][m][n] = __builtin_amdgcn_mfma_f32_16x16x32_bf16(Bt[n][k], At[m][k], acc[ai][bj][m][n], 0, 0, 0); __builtin_amdgcn_s_setprio(0); } while (0)
#define PG8_WAIT_V(n) asm volatile("s_waitcnt vmcnt(" #n ")" ::: "memory")
#define PG8_WAIT_L(n) asm volatile("s_waitcnt lgkmcnt(" #n ")" ::: "memory")
#define PG8_BAR __builtin_amdgcn_s_barrier()
#define PG8_SCHED __builtin_amdgcn_sched_barrier(0)
    Unit cur, nxt; int ui = 0;
    if (!S.next(0, cur)) return;
    f32x4 acc[2][2][4][2];
#pragma unroll
    for (int a = 0; a < 2; ++a)
#pragma unroll
        for (int b = 0; b < 2; ++b)
#pragma unroll
            for (int m = 0; m < 4; ++m)
#pragma unroll
                for (int n = 0; n < 2; ++n) acc[a][b][m][n] = (f32x4){0.f, 0.f, 0.f, 0.f};
    bf16x8 At[4][2], B0[2][2], B1[2][2];
    const char* cA = (const char*)g.A + (size_t)cur.pm * tstep + (size_t)cur.kt0 * kstep; const char* cB = (const char*)g.Bt + (size_t)cur.pn * tstep + (size_t)cur.kt0 * kstep;
    S.a_ready(cur);
    if constexpr (SP2) {
        PG8_STAGE(PG8_SB(0, 0), cB, voffB); PG8_STAGE(PG8_SB(0, 1), cB + hstep, voffB); PG8_STAGE(PG8_SA(0, 0), cA, voffA); PG8_STAGE(PG8_SA(0, 1), cA + hstep, voffA);
        if (wr == 1) PG8_BAR;
        PG8_WAIT_V(2); PG8_BAR;
        PG8_STAGE(PG8_SB(1, 0), cB + kstep, voffB); PG8_STAGE(PG8_SA(1, 0), cA + kstep, voffA); PG8_STAGE(PG8_SB(1, 1), cB + hstep + kstep, voffB);
        PG8_WAIT_V(6); PG8_BAR;
    } else {
        PG8_STAGE(PG8_SB(0, 0), cB, voffB); PG8_STAGE(PG8_SA(0, 0), cA, voffA); PG8_STAGE(PG8_SB(0, 1), cB + hstep, voffB); PG8_STAGE(PG8_SA(0, 1), cA + hstep, voffA);
        if (wr == 1) PG8_BAR;
        PG8_WAIT_V(4); PG8_BAR;
        PG8_STAGE(PG8_SB(1, 0), cB + kstep, voffB); PG8_STAGE(PG8_SA(1, 0), cA + kstep, voffA); PG8_STAGE(PG8_SB(1, 1), cB + hstep + kstep, voffB);
        PG8_WAIT_V(6); PG8_BAR;
    }
    for (;;) {
        const bool has_next = S.next(ui + 1, nxt);
        const char* nA = has_next ? (const char*)g.A + (size_t)nxt.pm * tstep + (size_t)nxt.kt0 * kstep : cA; const char* nB = has_next ? (const char*)g.Bt + (size_t)nxt.pn * tstep + (size_t)nxt.kt0 * kstep : cB;
        const int nt = cur.ntu;
        for (int t = 0; t < nt; t += 2) {
            const bool last = (t == nt - 2);
            const char* a1 = cA + (size_t)(t + 1) * kstep;
            const char* a2 = last ? nA : cA + (size_t)(t + 2) * kstep; const char* b2 = last ? nB : cB + (size_t)(t + 2) * kstep;
            const char* a3 = a2 + kstep; const char* b3 = b2 + kstep;
            if (last && has_next) S.a_ready(nxt);
            if constexpr (SP2) {
            PG8_LDB(B0, 0, 0); PG8_LDB(B1, 0, 1); PG8_SCHED; PG8_LDA(At, 0, 0); PG8_STAGE(PG8_SA(1, 1), a1 + hstep, voffA);
            PG8_WAIT_V(8); PG8_WAIT_L(0); PG8_BAR; PG8_MMA(0, 0, At, B0); PG8_MMA(0, 1, At, B1); PG8_BAR; PG8_SCHED;
            PG8_LDA(At, 0, 1); PG8_STAGE(PG8_SB(0, 0), b2, voffB); PG8_STAGE(PG8_SB(0, 1), b2 + hstep, voffB); PG8_STAGE(PG8_SA(0, 0), a2, voffA);
            PG8_WAIT_V(8); PG8_WAIT_L(0); PG8_BAR; PG8_MMA(1, 0, At, B0); PG8_MMA(1, 1, At, B1); PG8_BAR; PG8_SCHED;
            PG8_LDB(B0, 1, 0); PG8_LDB(B1, 1, 1); PG8_SCHED; PG8_LDA(At, 1, 0); PG8_STAGE(PG8_SA(0, 1), a2 + hstep, voffA);
            PG8_WAIT_V(8); PG8_WAIT_L(0); PG8_BAR; PG8_MMA(0, 0, At, B0); PG8_MMA(0, 1, At, B1); PG8_BAR; PG8_SCHED;
            PG8_LDA(At, 1, 1); PG8_STAGE(PG8_SB(1, 0), b3, voffB); PG8_STAGE(PG8_SB(1, 1), b3 + hstep, voffB); PG8_STAGE(PG8_SA(1, 0), a3, voffA);
            PG8_WAIT_V(8); PG8_WAIT_L(0); PG8_BAR; PG8_MMA(1, 0, At, B0); PG8_MMA(1, 1, At, B1); PG8_BAR; PG8_SCHED;
            } else {
            PG8_LDB(B0, 0, 0); PG8_SCHED; PG8_LDA(At, 0, 0); PG8_STAGE(PG8_SA(1, 1), a1 + hstep, voffA);
            PG8_WAIT_L(8); PG8_BAR; PG8_WAIT_L(0); PG8_MMA(0, 0, At, B0); PG8_BAR; PG8_SCHED;
            PG8_LDB(B1, 0, 1); PG8_STAGE(PG8_SB(0, 0), b2, voffB);
            PG8_BAR; PG8_WAIT_L(0); PG8_MMA(0, 1, At, B1); PG8_BAR;
            PG8_LDA(At, 0, 1); PG8_STAGE(PG8_SA(0, 0), a2, voffA);
            PG8_BAR; PG8_WAIT_L(0); PG8_MMA(1, 0, At, B0); PG8_BAR; PG8_SCHED;
            PG8_STAGE(PG8_SB(0, 1), b2 + hstep, voffB);
            PG8_WAIT_V(6); PG8_BAR; PG8_MMA(1, 1, At, B1); PG8_BAR;
            PG8_LDB(B0, 1, 0); PG8_SCHED; PG8_LDA(At, 1, 0); PG8_STAGE(PG8_SA(0, 1), a2 + hstep, voffA);
            PG8_WAIT_L(8); PG8_BAR; PG8_WAIT_L(0); PG8_MMA(0, 0, At, B0); PG8_BAR; PG8_SCHED;
            PG8_LDB(B1, 1, 1); PG8_STAGE(PG8_SB(1, 0), b3, voffB);
            PG8_BAR; PG8_WAIT_L(0); PG8_MMA(0, 1, At, B1); PG8_BAR;
            PG8_LDA(At, 1, 1); PG8_STAGE(PG8_SA(1, 0), a3, voffA);
            PG8_BAR; PG8_WAIT_L(0); PG8_MMA(1, 0, At, B0); PG8_BAR; PG8_SCHED;
            PG8_STAGE(PG8_SB(1, 1), b3 + hstep, voffB);
            PG8_WAIT_V(6); PG8_BAR; PG8_MMA(1, 1, At, B1); PG8_BAR;
            }
        }
        if constexpr (ALIGN_EPI) { if (wr == 0) PG8_BAR; }
        if constexpr (!Epi::AFTER_DRAIN) { E(acc, cur, wr, wc, fr, fq); S.done(cur); }
        if (!has_next) break;
#pragma unroll
        for (int a = 0; a < 2; ++a)
#pragma unroll
            for (int b = 0; b < 2; ++b)
#pragma unroll
                for (int m = 0; m < 4; ++m)
#pragma unroll
                    for (int n = 0; n < 2; ++n) acc[a][b][m][n] = (f32x4){0.f, 0.f, 0.f, 0.f};
        cur = nxt; cA = nA; cB = nB; ++ui;
        if constexpr (ALIGN_EPI) { if (wr == 1) PG8_BAR; }
    }
    PG8_WAIT_V(0);
    if constexpr (!ALIGN_EPI) { if (wr == 0) PG8_BAR; }
    PG8_BAR;
    if constexpr (Epi::AFTER_DRAIN) { E.fused(acc, cur, wr, wc, fr, fq, lds, wid, lane); S.done(cur); }
#undef PG8_SA
#undef PG8_SB
#undef PG8_STAGE
#undef PG8_LDA
#undef PG8_LDB
#undef PG8_MMA
#undef PG8_WAIT_V
#undef PG8_WAIT_L
#undef PG8_BAR
#undef PG8_SCHED
}
}
#ifndef PG8_SP2
#define PG8_SP2 true
#endif
#define GAS __attribute__((address_space(1)))
#define LAS __attribute__((address_space(3)))
typedef unsigned short bf16;
typedef unsigned v4u __attribute__((ext_vector_type(4)));
typedef float f32x4 __attribute__((ext_vector_type(4)));
typedef short bf16x8 __attribute__((ext_vector_type(8)));
typedef GAS unsigned gu32;
typedef GAS unsigned long long gu64;
#define RLX_AGENT __ATOMIC_RELAXED, __HIP_MEMORY_SCOPE_AGENT
#define LDS_WAIT() asm volatile("s_waitcnt lgkmcnt(0)" ::: "memory")
#define VM_WAIT() asm volatile("s_waitcnt vmcnt(0)" ::: "memory")
__device__ __forceinline__ unsigned long long rt() { return __builtin_amdgcn_s_memrealtime(); }
__device__ __forceinline__ unsigned f2bf(float f) { unsigned u = __builtin_bit_cast(unsigned, f); return (u + 0x7fffu + ((u >> 16) & 1u)) >> 16; }
__device__ __forceinline__ unsigned pk2(float lo, float hi) { return f2bf(lo) | (f2bf(hi) << 16); }

#define XB_TMO      128
#define XB_XCNT(j)  (256  + 64 * (j))
#define XB_XSUB(j)  (1280 + 64 * (j))
#define XB_XGEN(j)  (2304 + 64 * (j))
#define XB_TOP      3328
#define XB_TOPGEN   3392
#define XCD_BAR_WORDS 3456
#define XB_SPIN_CAP (1u << 18)

__device__ __forceinline__ unsigned xb_ld(unsigned* p)              { return __hip_atomic_load(p, __ATOMIC_RELAXED, __HIP_MEMORY_SCOPE_AGENT); }
__device__ __forceinline__ unsigned xb_add(unsigned* p, unsigned v) { return __hip_atomic_fetch_add(p, v, __ATOMIC_RELAXED, __HIP_MEMORY_SCOPE_AGENT); }
__device__ __forceinline__ unsigned xb_xcc_id() { return (unsigned)__builtin_amdgcn_s_getreg((3 << 11) | 20) & 0xFu; }
#define XB_SPIN(cond, bar) do { unsigned _sp = 0; while (cond) { __builtin_amdgcn_s_sleep(1); \
    if ((++_sp & 255u) == 0u) { if (xb_ld(&(bar)[XB_TMO])) break; if (_sp > XB_SPIN_CAP) { atomicAdd(&(bar)[XB_TMO], 1u); break; } } } } while (0)

struct XcdBarrier {
    unsigned* bar; unsigned x;
    volatile LAS unsigned* st;
};

__device__ __forceinline__ XcdBarrier xcd_barrier_post(unsigned* bar, volatile LAS unsigned* st) {
    XcdBarrier b; b.bar = bar; b.x = xb_xcc_id(); b.st = st;
    if (threadIdx.x == 0) (void)xb_add(&bar[XB_XCNT(b.x)], 1u);
    return b;
}
__device__ __forceinline__ void xcd_barrier_complete(unsigned* bar, unsigned x, unsigned& nloc, unsigned& nx) {
    const unsigned G = gridDim.x * gridDim.y * gridDim.z;
    unsigned sum, cnt, mine, sp = 0u;
    for (;;) {
        sum = 0u; cnt = 0u; mine = 0u;
#pragma unroll
        for (unsigned j = 0; j < 16; ++j) { const unsigned c = xb_ld(&bar[XB_XCNT(j)]); sum += c; cnt += (c > 0u) ? 1u : 0u; mine = (j == x) ? c : mine; }
        if (sum == G) break;
        __builtin_amdgcn_s_sleep(1);
        if ((++sp & 255u) == 0u) { if (xb_ld(&bar[XB_TMO])) break; if (sp > XB_SPIN_CAP) { atomicAdd(&bar[XB_TMO], 1u); break; } }
    }
    nloc = mine > 0u ? mine : 1u; nx = cnt > 0u ? cnt : 1u;
}

__device__ __forceinline__ void xcd_barrier(const XcdBarrier& b) {
    asm volatile("s_waitcnt vmcnt(0)" ::: "memory");
    __syncthreads();
    if (threadIdx.x == 0) {
        unsigned* bar = b.bar;
        __builtin_amdgcn_s_waitcnt(0);
        unsigned nloc = b.st[0], nx = b.st[1];
        if (nloc == 0u) { xcd_barrier_complete(bar, b.x, nloc, nx); b.st[0] = nloc; b.st[1] = nx; }
        const unsigned old = xb_add(&bar[XB_XSUB(b.x)], 1u);
        const unsigned gen = old / nloc;
        if (old + 1u == (gen + 1u) * nloc) {
            __builtin_amdgcn_fence(__ATOMIC_RELEASE, "agent");
            asm volatile("s_waitcnt vmcnt(0)" ::: "memory");
            const unsigned og = xb_add(&bar[XB_TOP], 1u);
            const unsigned tg = og / nx;
            if (og + 1u == (tg + 1u) * nx) xb_add(&bar[XB_TOPGEN], 1u);
            else XB_SPIN(xb_ld(&bar[XB_TOPGEN]) == tg, bar);
            __builtin_amdgcn_fence(__ATOMIC_ACQUIRE, "agent");
            xb_add(&bar[XB_XGEN(b.x)], 1u);
            asm volatile("s_waitcnt vmcnt(0)" ::: "memory");
        } else {
            XB_SPIN(xb_ld(&bar[XB_XGEN(b.x)]) == gen, bar);
            __builtin_amdgcn_fence(__ATOMIC_ACQUIRE, "agent");
            asm volatile("s_waitcnt vmcnt(0)" ::: "memory");
        }
    }
    __syncthreads();
}


constexpr int NWAVES = 8;
constexpr int DM = 1024, NBP = 4, SEQ = 8192, NBS = 32, DSEQ = 64, NMETA = 16;
constexpr int DCONV = 512, NH = 4, DH = 128, DRET = 512, DFF = 4096, DIN = 3584;
constexpr int MP = NBP * SEQ, MS = NBS * DSEQ, M = MP + MS;
constexpr float NORM_EPS = 1e-6f, GN_EPS = 1e-5f;
static_assert(MP == pg8::ROWS_P && M % 256 == 0, "row geometry");
constexpr size_t O_Y = 0, O_CONVP = (size_t)M * DM, O_RETP = O_CONVP + NBP * 2 * DCONV, O_CONVS = O_RETP + (size_t)NBP * NH * DH * DH, O_RETS = O_CONVS + NBS * 2 * DCONV,
                 O_END = O_RETS + (size_t)NBS * NH * DH * DH;
constexpr size_t MiB = 1u << 20;
constexpr size_t WS_CTL = 0, CTL_ZERO_BYTES = 1 * MiB;
constexpr size_t WS_RSTD1 = 1 * MiB, WS_SSQ1 = 2 * MiB, WS_SSQ2 = 5 * MiB, WS_ROPE = 8 * MiB, WS_META = 12 * MiB;
constexpr size_t WS_WIN = 16 * MiB, WS_WOUT = 24 * MiB, WS_WUP = 26 * MiB, WS_WDN = 34 * MiB;
constexpr size_t WS_XB = 48 * MiB;
constexpr size_t WS_U = 116 * MiB, WS_BG = 150 * MiB, WS_Q = 184 * MiB, WS_K = 218 * MiB, WS_V = 252 * MiB, WS_SG = 286 * MiB;
constexpr size_t WS_MIX = 320 * MiB;
constexpr size_t WS_PART = 48 * MiB;
constexpr size_t WS_ACT = 116 * MiB;
constexpr size_t WS_TG = 388 * MiB, WS_GG = 404 * MiB, WS_SMETA = 420 * MiB;
constexpr size_t WS_END = 421 * MiB;
static_assert(WS_BG - WS_U == (size_t)M * 512 * 2 && WS_Q - WS_BG == WS_BG - WS_U && WS_K - WS_Q == WS_BG - WS_U && WS_V - WS_K == WS_BG - WS_U && WS_SG - WS_V == WS_BG - WS_U, "six bf16 regions back to back");
static_assert(WS_XB + (size_t)M * DM * 2 <= WS_U && WS_SG + (size_t)M * 512 * 2 <= WS_MIX && WS_MIX + (size_t)M * DM * 2 <= WS_TG && WS_ACT + (size_t)M * DFF * 2 <= WS_TG, "ws map");
static_assert(WS_SSQ1 + (size_t)M * 16 * 4 <= WS_SSQ2 && WS_SSQ2 + (size_t)M * 16 * 4 <= WS_ROPE && WS_ROPE + (size_t)8192 * 64 * 8 <= WS_META, "ws map small");
constexpr int CW_TMO = 0, CW_BAR = 4096;
constexpr int RING_OFF = 0, RING_BYTES = 131072, LDSCTL_OFF = RING_BYTES, MISC_OFF = LDSCTL_OFF + 320, LDS_BYTES = 147456;

struct Frame {
    LAS unsigned char* lds;
    volatile LAS unsigned* MISC;
    gu32* ctl;
    int tid, lane, wave, vcu, G;
    const float* in[14];
    float* out;
    unsigned char* ws;
};
__device__ __forceinline__ float wave_sum(float v) {
#pragma unroll
    for (int o = 1; o < 64; o <<= 1) v += __shfl_xor(v, o);
    return v;
}
__device__ __forceinline__ float bf2f(unsigned short b) { return __builtin_bit_cast(float, (unsigned)b << 16); }

__device__ __forceinline__ int win_src_col(int n0, float& sc) {
    const int pn = n0 >> 8, lc = n0 & 255; sc = 1.0f;
    if (pn < 4) return (lc < 128) ? (128 * pn + lc) : (1024 + 128 * pn + (lc - 128));
    if (pn < 6) return 512 + 256 * (pn - 4) + lc;
    if (pn < 10) { const int isk = (pn >= 8) ? 1 : 0, hp = (pn - 6) & 1, half = lc >> 7, l2 = lc & 127, head = 2 * hp + (l2 >> 6), i = l2 & 63; if (isk) sc = 0.08838834764831845f;
        return 1536 + 512 * isk + 128 * head + 64 * half + i; }
    if (pn < 12) return 2560 + 256 * (pn - 10) + lc;
    return 3072 + 256 * (pn - 12) + lc;
}
__device__ __forceinline__ void p0_transpose_item(const float* W, int K, int N, bf16* WT, int k0, int n0, int src0, const float* ks, float cs, LAS float* scr, int lane) {
#pragma unroll 8
    for (int i = 0; i < 32; ++i) { const int kk = 2 * i + (lane >> 5); const float s = ks ? ks[k0 + kk] * cs : cs; scr[kk * 33 + (lane & 31)] = W[(size_t)(k0 + kk) * N + src0 + (lane & 31)] * s; }
    LDS_WAIT(); asm volatile("" ::: "memory");
    const int c = lane & 7;
#pragma unroll
    for (int j = 0; j < 4; ++j) { const int n = (lane >> 3) + 8 * j; const LAS float* s = scr + (8 * c) * 33 + n;
        v4u o; o.x = pk2(s[0 * 33], s[1 * 33]); o.y = pk2(s[2 * 33], s[3 * 33]); o.z = pk2(s[4 * 33], s[5 * 33]); o.w = pk2(s[6 * 33], s[7 * 33]);
        *(GAS v4u*)(WT + (size_t)(n0 + n) * K + k0 + 8 * c) = o; }
    LDS_WAIT(); asm volatile("" ::: "memory");
}
__device__ __forceinline__ void x_row_to_bf16(int lane, const float* xrow, bf16* orow, float* rstd_out) {
    const GAS f32x4* xr = (const GAS f32x4*)xrow + lane;
    f32x4 v[4]; float s = 0.f;
#pragma unroll
    for (int j = 0; j < 4; ++j) { v[j] = xr[64 * j]; s += (v[j].x * v[j].x + v[j].y * v[j].y) + (v[j].z * v[j].z + v[j].w * v[j].w); }
    s = wave_sum(s);
    GAS unsigned long long* o8 = (GAS unsigned long long*)orow + lane;
#pragma unroll
    for (int j = 0; j < 4; ++j) o8[64 * j] = (unsigned long long)pk2(v[j].x, v[j].y) | ((unsigned long long)pk2(v[j].z, v[j].w) << 32);
    if (lane == 0) *rstd_out = 1.0f / sqrtf(s * (1.0f / DM) + NORM_EPS);
}
__device__ __forceinline__ void p0_prologue(Frame& F) {
    LAS float* scr = (LAS float*)(F.lds + RING_OFF + F.wave * 16384);
    const int gw = F.vcu * NWAVES + F.wave, NGW = F.G * NWAVES;
    const float* w_in = F.in[6]; const float* w_out = F.in[9]; const float* w_up = F.in[11]; const float* w_dn = F.in[12];
    bf16* WIN = (bf16*)(F.ws + WS_WIN); bf16* WOUT = (bf16*)(F.ws + WS_WOUT); bf16* WUP = (bf16*)(F.ws + WS_WUP); bf16* WDN = (bf16*)(F.ws + WS_WDN);
    constexpr int I_IN = (DM / 64) * (DIN / 32), I_OUT = (DM / 64) * (DM / 32), I_UP = (DM / 64) * (DFF / 32), I_DN = (DFF / 64) * (DM / 32);
    constexpr int NITEMS = I_IN + I_OUT + I_UP + I_DN;
    for (int it = gw; it < NITEMS; it += NGW) {
        int r = it;
        if (r < I_IN) { const int nblk = DIN / 32, kb = r / nblk, nb = r % nblk; float cs; const int src0 = win_src_col(32 * nb, cs);
            p0_transpose_item(w_in, DM, DIN, WIN, 64 * kb, 32 * nb, src0, F.in[5], cs, scr, F.lane); continue; } r -= I_IN;
        if (r < I_OUT) { const int nblk = DM / 32, kb = r / nblk, nb = r % nblk; p0_transpose_item(w_out, DM, DM, WOUT, 64 * kb, 32 * nb, 32 * nb, nullptr, 1.0f, scr, F.lane); continue; } r -= I_OUT;
        if (r < I_UP) { const int nblk = DFF / 32, kb = r / nblk, nb = r % nblk; p0_transpose_item(w_up, DM, DFF, WUP, 64 * kb, 32 * nb, 32 * nb, F.in[10], 1.0f, scr, F.lane); continue; } r -= I_UP;
        { const int nblk = DM / 32, kb = r / nblk, nb = r % nblk; p0_transpose_item(w_dn, DFF, DM, WDN, 64 * kb, 32 * nb, 32 * nb, nullptr, 1.0f, scr, F.lane); }
    }
    bf16* XB = (bf16*)(F.ws + WS_XB); float* RS = (float*)(F.ws + WS_RSTD1);
    for (int m = gw; m < M; m += NGW) { const float* xrow = (m < MP) ? F.in[0] + (size_t)m * DM : F.in[1] + (size_t)(m - MP) * DM; x_row_to_bf16(F.lane, xrow, XB + (size_t)m * DM, RS + m); }
    float* ROPE = (float*)(F.ws + WS_ROPE);
    for (int e = (F.vcu * NWAVES * 64) + F.tid; e < 8192 * 64; e += F.G * NWAVES * 64) { const int pos = e >> 6, i = e & 63;
        const float invf = (float)exp2(-(double)i * (13.287712379549449 / 64.0));
        const double rev = (double)((float)pos * invf) * 0.15915494309189535;
        const float fr = (float)(rev - __builtin_rint(rev));
        ROPE[2 * e] = __builtin_amdgcn_cosf(fr); ROPE[2 * e + 1] = __builtin_amdgcn_sinf(fr); }
}

__device__ __forceinline__ void meta_proj(Frame& F) {
    LAS float* hm = (LAS float*)(F.lds + RING_OFF);
    const float* meta = F.in[4];
    for (int rr = 0; rr < 2; ++rr) { const int row = F.wave * 2 + rr; const GAS f32x4* xr = (const GAS f32x4*)(meta + (size_t)row * DM) + F.lane;
        f32x4 v[4]; float s = 0.f;
#pragma unroll
        for (int j = 0; j < 4; ++j) { v[j] = xr[64 * j]; s += (v[j].x * v[j].x + v[j].y * v[j].y) + (v[j].z * v[j].z + v[j].w * v[j].w); }
        const float rs = 1.0f / sqrtf(wave_sum(s) * (1.0f / DM) + NORM_EPS);
#pragma unroll
        for (int j = 0; j < 4; ++j) *(LAS f32x4*)(hm + row * DM + 4 * (F.lane + 64 * j)) = v[j] * rs; }
    LDS_WAIT(); __syncthreads();
    const bf16* WIN = (const bf16*)(F.ws + WS_WIN); float* MPJ = (float*)(F.ws + WS_META);
    const int gw = F.vcu * NWAVES + F.wave, NGW = F.G * NWAVES;
    for (int n = gw; n < DIN; n += NGW) {
        const GAS v4u* wp = (const GAS v4u*)(WIN + (size_t)n * DM + 16 * F.lane); const v4u w0 = wp[0], w1 = wp[1];
        float wv[16];
        wv[0] = bf2f(w0.x & 0xffff); wv[1] = bf2f(w0.x >> 16); wv[2] = bf2f(w0.y & 0xffff); wv[3] = bf2f(w0.y >> 16); wv[4] = bf2f(w0.z & 0xffff); wv[5] = bf2f(w0.z >> 16); wv[6] = bf2f(w0.w & 0xffff); wv[7] = bf2f(w0.w >> 16);
        wv[8] = bf2f(w1.x & 0xffff); wv[9] = bf2f(w1.x >> 16); wv[10] = bf2f(w1.y & 0xffff); wv[11] = bf2f(w1.y >> 16); wv[12] = bf2f(w1.z & 0xffff); wv[13] = bf2f(w1.z >> 16); wv[14] = bf2f(w1.w & 0xffff); wv[15] = bf2f(w1.w >> 16);
        float res = 0.f;
#pragma unroll 2
        for (int row = 0; row < 16; ++row) { const LAS f32x4* h = (const LAS f32x4*)(hm + row * DM + 16 * F.lane); float a = 0.f;
#pragma unroll
            for (int q = 0; q < 4; ++q) { const f32x4 hv = h[q]; a += hv.x * wv[4 * q] + hv.y * wv[4 * q + 1] + hv.z * wv[4 * q + 2] + hv.w * wv[4 * q + 3]; }
            a = wave_sum(a); if (F.lane == row) res = a; }
        if (F.lane < 16) MPJ[(size_t)F.lane * DIN + n] = res;
    }
}
__device__ __forceinline__ int mcol_xt(int c) { return 256 * (c >> 7) + (c & 127); }
__device__ __forceinline__ int mcol_cg(int c) { return 256 * (c >> 7) + 128 + (c & 127); }
__device__ __forceinline__ int mcol_k(int head, int d) { return 256 * (8 + (head >> 1)) + 128 * (d >> 6) + 64 * (head & 1) + (d & 63); }
__device__ __forceinline__ int mcol_v(int head, int e) { return 2560 + 128 * head + e; }

__device__ __forceinline__ void conv_phase(Frame& F) {
    const bf16* U = (const bf16*)(F.ws + WS_U); const bf16* BG = (const bf16*)(F.ws + WS_BG); bf16* MIX = (bf16*)(F.ws + WS_MIX);
    const float* MPJ = (const float*)(F.ws + WS_META); const float* cw = F.in[7]; const float* sconv = F.in[2];
    const int nthr = F.G * NWAVES * 64;
    for (int item = F.vcu * NWAVES * 64 + F.tid; item < M * 64; item += nthr) {
        const int r = item >> 6, c8 = (item & 63) * 8; const bool pr = r < MP; const int t = pr ? (r & 8191) : (r & 63), T = pr ? SEQ : DSEQ;
        float u0[8], u1[8], u2[8], bg[8];
        { const v4u a = *(const GAS v4u*)(U + (size_t)r * 512 + c8); u0[0] = bf2f(a.x & 0xffff); u0[1] = bf2f(a.x >> 16); u0[2] = bf2f(a.y & 0xffff); u0[3] = bf2f(a.y >> 16); u0[4] = bf2f(a.z & 0xffff); u0[5] = bf2f(a.z >> 16); u0[6] = bf2f(a.w & 0xffff); u0[7] = bf2f(a.w >> 16); }
        { const v4u a = *(const GAS v4u*)(BG + (size_t)r * 512 + c8); bg[0] = bf2f(a.x & 0xffff); bg[1] = bf2f(a.x >> 16); bg[2] = bf2f(a.y & 0xffff); bg[3] = bf2f(a.y >> 16); bg[4] = bf2f(a.z & 0xffff); bg[5] = bf2f(a.z >> 16); bg[6] = bf2f(a.w & 0xffff); bg[7] = bf2f(a.w >> 16); }
        if (t >= 1) { const v4u a = *(const GAS v4u*)(U + (size_t)(r - 1) * 512 + c8); u1[0] = bf2f(a.x & 0xffff); u1[1] = bf2f(a.x >> 16); u1[2] = bf2f(a.y & 0xffff); u1[3] = bf2f(a.y >> 16); u1[4] = bf2f(a.z & 0xffff); u1[5] = bf2f(a.z >> 16); u1[6] = bf2f(a.w & 0xffff); u1[7] = bf2f(a.w >> 16); }
        if (t >= 2) { const v4u a = *(const GAS v4u*)(U + (size_t)(r - 2) * 512 + c8); u2[0] = bf2f(a.x & 0xffff); u2[1] = bf2f(a.x >> 16); u2[2] = bf2f(a.y & 0xffff); u2[3] = bf2f(a.y >> 16); u2[4] = bf2f(a.z & 0xffff); u2[5] = bf2f(a.z >> 16); u2[6] = bf2f(a.w & 0xffff); u2[7] = bf2f(a.w >> 16); }
        if (t < 2) {
#pragma unroll
            for (int j = 0; j < 8; ++j) { const int c = c8 + j; float h0, h1;
                if (pr) { h0 = MPJ[(size_t)14 * DIN + mcol_xt(c)] * MPJ[(size_t)14 * DIN + mcol_cg(c)]; h1 = MPJ[(size_t)15 * DIN + mcol_xt(c)] * MPJ[(size_t)15 * DIN + mcol_cg(c)]; }
                else { const int s = (r - MP) >> 6; h0 = sconv[((size_t)s * 2 + 0) * DCONV + c]; h1 = sconv[((size_t)s * 2 + 1) * DCONV + c]; }
                if (t == 0) { u1[j] = h1; u2[j] = h0; } else { u2[j] = h1; } }
        }
        float o[8];
#pragma unroll
        for (int j = 0; j < 8; ++j) { const int c = c8 + j; o[j] = bg[j] * (cw[c] * u2[j] + cw[DCONV + c] * u1[j] + cw[2 * DCONV + c] * u0[j]); }
        v4u w; w.x = pk2(o[0], o[1]); w.y = pk2(o[2], o[3]); w.z = pk2(o[4], o[5]); w.w = pk2(o[6], o[7]);
        *(GAS v4u*)(MIX + (size_t)r * DM + c8) = w;
        if (t >= T - 2) { float* dst = pr ? F.out + O_CONVP + ((size_t)(r >> 13) * 2 + (t - (T - 2))) * DCONV + c8 : F.out + O_CONVS + ((size_t)((r - MP) >> 6) * 2 + (t - (T - 2))) * DCONV + c8;
            *(f32x4*)dst = (f32x4){u0[0], u0[1], u0[2], u0[3]}; *(f32x4*)(dst + 4) = (f32x4){u0[4], u0[5], u0[6], u0[7]}; }
    }
}

namespace ret {
constexpr int QS = 0, KS = 17408, KT = 34816, VT = 53248, AS = 71680, ST = 80896;
constexpr int QSTR = 272, TSTR = 144;
__device__ __forceinline__ unsigned short el16(const v4u& w, int k) { const unsigned x = (k >> 1) == 0 ? w.x : (k >> 1) == 1 ? w.y : (k >> 1) == 2 ? w.z : w.w; return (k & 1) ? (unsigned short)(x >> 16) : (unsigned short)(x & 0xffffu); }
typedef unsigned long long u64;
typedef float f32x2 __attribute__((ext_vector_type(2)));

template <bool FULL>
__device__ __forceinline__ void ret_task(Frame& F, int row0, int nchunks, int head, const float* s_init_native, const float* s_init_de, float* s_out_native, float* s_out_de) {
    const int lane = F.lane, w = F.wave, q = lane >> 4, c15 = lane & 15;
    LAS unsigned char* L = F.lds;
    const bf16* Qg = (const bf16*)(F.ws + WS_Q); const bf16* Kg = (const bf16*)(F.ws + WS_K); const bf16* Vg = (const bf16*)(F.ws + WS_V); const bf16* SGg = (const bf16*)(F.ws + WS_SG);
    bf16* MIX = (bf16*)(F.ws + WS_MIX);
    const float lg2 = log2f(1.0f - exp2f(-5.0f - (float)head));
    const float dec = exp2f(lg2 * (float)(63 - lane)), g64 = exp2f(lg2 * 64.0f);
    f32x4 S[8];
    if (s_init_native) {
#pragma unroll
        for (int db = 0; db < 8; ++db) S[db] = *(const f32x4*)(s_init_native + ((size_t)(w * 8 + db) * 64 + lane) * 4);
    } else if (s_init_de) {
#pragma unroll
        for (int db = 0; db < 8; ++db)
#pragma unroll
            for (int r = 0; r < 4; ++r) S[db][r] = s_init_de[(size_t)(16 * db + 4 * q + r) * 128 + 16 * w + c15];
    } else {
#pragma unroll
        for (int db = 0; db < 8; ++db) S[db] = (f32x4){0.f, 0.f, 0.f, 0.f};
    }
    float cd[4]; f32x4 gw4 = (f32x4){0.f, 0.f, 0.f, 0.f};
    if (FULL) {
#pragma unroll
        for (int ib = 0; ib < 4; ++ib) cd[ib] = exp2f(lg2 * (float)(16 * ib + c15 + 1));
        gw4 = *(const f32x4*)(F.in[8] + 128 * head + 16 * w + 4 * q);
    }
    v4u pq[2], pk[2], pv[2];
#define RET_ISSUE(ch) do { _Pragma("unroll") for (int pi = 0; pi < 2; ++pi) { const size_t off = (size_t)(row0 + (ch) * 64 + lane) * 512 + 128 * head + 8 * (w + 8 * pi); \
        if (FULL) pq[pi] = *(const GAS v4u*)(Qg + off); pk[pi] = *(const GAS v4u*)(Kg + off); pv[pi] = *(const GAS v4u*)(Vg + off); } } while (0)
    RET_ISSUE(0);
    for (int ch = 0; ch < nchunks; ++ch) {
#pragma unroll
        for (int pi = 0; pi < 2; ++pi) { const int c = w + 8 * pi;
            if (FULL) { *(LAS v4u*)(L + QS + lane * QSTR + 16 * c) = pq[pi]; *(LAS v4u*)(L + KS + lane * QSTR + 16 * c) = pk[pi]; }
#pragma unroll
            for (int k = 0; k < 8; ++k) { *(LAS unsigned short*)(L + KT + (8 * c + k) * TSTR + 2 * lane) = (unsigned short)f2bf(bf2f(el16(pk[pi], k)) * dec);
                *(LAS unsigned short*)(L + VT + (8 * c + k) * TSTR + 2 * lane) = el16(pv[pi], k); } }
        if (ch + 1 < nchunks) RET_ISSUE(ch + 1);
        LDS_WAIT(); __builtin_amdgcn_s_barrier(); asm volatile("" ::: "memory");
        if (FULL) {
            const int mi = w >> 1;
#pragma unroll
            for (int t = 0; t < 2; ++t) { const int nj = 2 * (w & 1) + t; f32x4 a4 = (f32x4){0.f, 0.f, 0.f, 0.f};
#pragma unroll
                for (int s = 0; s < 4; ++s) { const bf16x8 a = *(const LAS bf16x8*)(L + KS + (16 * nj + c15) * QSTR + (32 * s + 8 * q) * 2), b = *(const LAS bf16x8*)(L + QS + (16 * mi + c15) * QSTR + (32 * s + 8 * q) * 2);
                    a4 = __builtin_amdgcn_mfma_f32_16x16x32_bf16(a, b, a4, 0, 0, 0); }
                const int i = 16 * mi + c15; float v[4];
#pragma unroll
                for (int r = 0; r < 4; ++r) { const int j = 16 * nj + 4 * q + r; v[r] = (i >= j) ? a4[r] * exp2f(lg2 * (float)(i - j)) : 0.f; }
                *(LAS u64*)(L + AS + i * TSTR + (16 * nj + 4 * q) * 2) = (u64)pk2(v[0], v[1]) | ((u64)pk2(v[2], v[3]) << 32); }
            LDS_WAIT(); __builtin_amdgcn_s_barrier(); asm volatile("" ::: "memory");
        }
        bf16x8 vt[2];
#pragma unroll
        for (int s = 0; s < 2; ++s) vt[s] = *(const LAS bf16x8*)(L + VT + (16 * w + c15) * TSTR + (32 * s + 8 * q) * 2);
        f32x4 acc[4];
        if (FULL) {
#pragma unroll
            for (int ib = 0; ib < 4; ++ib) acc[ib] = (f32x4){0.f, 0.f, 0.f, 0.f};
#pragma unroll
            for (int s = 0; s < 4; ++s) { v4u aw; aw.x = pk2(S[2 * s][0], S[2 * s][1]); aw.y = pk2(S[2 * s][2], S[2 * s][3]); aw.z = pk2(S[2 * s + 1][0], S[2 * s + 1][1]); aw.w = pk2(S[2 * s + 1][2], S[2 * s + 1][3]);
                const bf16x8 a = __builtin_bit_cast(bf16x8, aw);
#pragma unroll
                for (int ib = 0; ib < 4; ++ib) { const u64 lo = *(const LAS u64*)(L + QS + (16 * ib + c15) * QSTR + (32 * s + 4 * q) * 2), hi = *(const LAS u64*)(L + QS + (16 * ib + c15) * QSTR + (32 * s + 16 + 4 * q) * 2);
                    v4u bw; bw.x = (unsigned)lo; bw.y = (unsigned)(lo >> 32); bw.z = (unsigned)hi; bw.w = (unsigned)(hi >> 32);
                    acc[ib] = __builtin_amdgcn_mfma_f32_16x16x32_bf16(a, __builtin_bit_cast(bf16x8, bw), acc[ib], 0, 0, 0); } }
#pragma unroll
            for (int ib = 0; ib < 4; ++ib) acc[ib] = acc[ib] * cd[ib];
#pragma unroll
            for (int ib = 0; ib < 4; ++ib)
#pragma unroll
                for (int s = 0; s < 2; ++s) { if (s == 1 && ib < 2) continue;
                    const bf16x8 b = *(const LAS bf16x8*)(L + AS + (16 * ib + c15) * TSTR + (32 * s + 8 * q) * 2);
                    acc[ib] = __builtin_amdgcn_mfma_f32_16x16x32_bf16(vt[s], b, acc[ib], 0, 0, 0); }
        }
#pragma unroll
        for (int db = 0; db < 8; ++db) { S[db] = S[db] * g64;
#pragma unroll
            for (int s = 0; s < 2; ++s) { const bf16x8 a = *(const LAS bf16x8*)(L + KT + (16 * db + c15) * TSTR + (32 * s + 8 * q) * 2);
                S[db] = __builtin_amdgcn_mfma_f32_16x16x32_bf16(a, vt[s], S[db], 0, 0, 0); } }
        if (FULL) {
#pragma unroll
            for (int ib = 0; ib < 4; ++ib) { float s1 = (acc[ib][0] + acc[ib][1]) + (acc[ib][2] + acc[ib][3]); s1 += __shfl_xor(s1, 16); s1 += __shfl_xor(s1, 32);
                const float mw = s1 * (1.0f / 16.0f); const f32x4 dd = acc[ib] - mw; float m2 = (dd[0] * dd[0] + dd[1] * dd[1]) + (dd[2] * dd[2] + dd[3] * dd[3]); m2 += __shfl_xor(m2, 16); m2 += __shfl_xor(m2, 32);
                if (q == 0) *(LAS f32x2*)(L + ST + ((16 * ib + c15) * 8 + w) * 8) = (f32x2){mw, m2}; }
            LDS_WAIT(); __builtin_amdgcn_s_barrier(); asm volatile("" ::: "memory");
#pragma unroll
            for (int ib = 0; ib < 4; ++ib) { const int i = 16 * ib + c15; const LAS f32x4* sp = (const LAS f32x4*)(L + ST + i * 64);
                const f32x4 p0 = sp[0], p1 = sp[1], p2 = sp[2], p3 = sp[3];
                const float mean = ((p0[0] + p0[2]) + (p1[0] + p1[2]) + (p2[0] + p2[2]) + (p3[0] + p3[2])) * 0.125f;
                const float d0 = p0[0] - mean, d1 = p0[2] - mean, d2 = p1[0] - mean, d3 = p1[2] - mean, d4 = p2[0] - mean, d5 = p2[2] - mean, d6 = p3[0] - mean, d7 = p3[2] - mean;
                const float M2 = ((p0[1] + p0[3]) + (p1[1] + p1[3]) + (p2[1] + p2[3]) + (p3[1] + p3[3])) + 16.0f * ((d0 * d0 + d1 * d1) + (d2 * d2 + d3 * d3) + (d4 * d4 + d5 * d5) + (d6 * d6 + d7 * d7));
                const float rsd = 1.0f / sqrtf(M2 * (1.0f / 128.0f) + GN_EPS);
                const size_t row = (size_t)(row0 + ch * 64 + i); const int cc = 128 * head + 16 * w + 4 * q;
                const u64 sgw = *(const GAS u64*)(SGg + row * 512 + cc);
                const float o0 = (acc[ib][0] - mean) * rsd * gw4[0] * bf2f((unsigned short)(sgw & 0xffff)), o1 = (acc[ib][1] - mean) * rsd * gw4[1] * bf2f((unsigned short)((sgw >> 16) & 0xffff));
                const float o2 = (acc[ib][2] - mean) * rsd * gw4[2] * bf2f((unsigned short)((sgw >> 32) & 0xffff)), o3 = (acc[ib][3] - mean) * rsd * gw4[3] * bf2f((unsigned short)(sgw >> 48));
                *(GAS u64*)(MIX + row * DM + 512 + cc) = (u64)pk2(o0, o1) | ((u64)pk2(o2, o3) << 32); }
        } else {
            LDS_WAIT(); __builtin_amdgcn_s_barrier(); asm volatile("" ::: "memory");
        }
    }
#undef RET_ISSUE
    if (s_out_native) {
#pragma unroll
        for (int db = 0; db < 8; ++db) *(f32x4*)(s_out_native + ((size_t)(w * 8 + db) * 64 + lane) * 4) = S[db];
    }
    if (s_out_de) {
#pragma unroll
        for (int db = 0; db < 8; ++db)
#pragma unroll
            for (int r = 0; r < 4; ++r) s_out_de[(size_t)(16 * db + 4 * q + r) * 128 + 16 * w + c15] = S[db][r];
    }
    __syncthreads();
}
__device__ __forceinline__ void smeta_task(Frame& F, int head, float* out_native) {
    LAS float* km = (LAS float*)(F.lds); LAS float* vm = km + 2048;
    const float* MPJ = (const float*)(F.ws + WS_META); const float* ROPE = (const float*)(F.ws + WS_ROPE);
    const float lg2 = log2f(1.0f - exp2f(-5.0f - (float)head));
    __syncthreads();
    for (int idx = F.tid; idx < 2048; idx += 512) { const int j = idx >> 7, d = idx & 127, i = d & 63, ap = 16 - j;
        const float x1 = MPJ[(size_t)j * DIN + mcol_k(head, i)], x2 = MPJ[(size_t)j * DIN + mcol_k(head, 64 + i)];
        const float c = ROPE[2 * (ap * 64 + i)], s = -ROPE[2 * (ap * 64 + i) + 1];
        km[idx] = ((d < 64) ? (x1 * c - x2 * s) : (x1 * s + x2 * c)) * exp2f(lg2 * (float)(15 - j));
        vm[idx] = MPJ[(size_t)j * DIN + mcol_v(head, d)]; }
    LDS_WAIT(); __syncthreads();
    const int lane = F.lane, w = F.wave, q = lane >> 4, c15 = lane & 15;
    for (int db = 0; db < 8; ++db) { f32x4 o;
#pragma unroll
        for (int r = 0; r < 4; ++r) { const int d = 16 * db + 4 * q + r, e = 16 * w + c15; float a = 0.f;
            for (int j = 0; j < 16; ++j) a += km[j * 128 + d] * vm[j * 128 + e];
            o[r] = a; }
        *(f32x4*)(out_native + ((size_t)(w * 8 + db) * 64 + lane) * 4) = o; }
    __syncthreads();
}
}
#if RET_ORACLE
__device__ __forceinline__ void ret_oracle_task(Frame& F, int stream, int head, bf16* MIXO, float* retp, float* rets) {
    LAS float* S = (LAS float*)(F.lds);
    LAS bf16* qs = (LAS bf16*)(F.lds + 65536); LAS bf16* ks = (LAS bf16*)(F.lds + 81920); LAS bf16* vs = (LAS bf16*)(F.lds + 98304);
    LAS float* sc = (LAS float*)(F.lds + 114688);
    const bf16* Q = (const bf16*)(F.ws + WS_Q); const bf16* Kb = (const bf16*)(F.ws + WS_K); const bf16* V = (const bf16*)(F.ws + WS_V); const bf16* SG = (const bf16*)(F.ws + WS_SG);
    const float* MPJ = (const float*)(F.ws + WS_META); const float* ROPE = (const float*)(F.ws + WS_ROPE); const float* gnw = F.in[8];
    const float lg = logf(1.0f - exp2f(-5.0f - (float)head));
    const bool pr = stream < NBP; const int tid = F.tid;
    __syncthreads();
    if (pr) {
        LAS float* km = sc; LAS float* vm = sc + 2048;
        for (int idx = tid; idx < 2048; idx += 512) { const int j = idx >> 7, d = idx & 127, i = d & 63, ap = 16 - j;
            const float x1 = MPJ[(size_t)j * DIN + mcol_k(head, i)], x2 = MPJ[(size_t)j * DIN + mcol_k(head, 64 + i)];
            const float c = ROPE[2 * (ap * 64 + i)], s = -ROPE[2 * (ap * 64 + i) + 1];
            km[idx] = (d < 64) ? (x1 * c - x2 * s) : (x1 * s + x2 * c);
            vm[idx] = MPJ[(size_t)j * DIN + mcol_v(head, d)]; }
        LDS_WAIT(); __syncthreads();
        for (int idx = tid; idx < 16384; idx += 512) { const int d = idx >> 7, e = idx & 127; float a = 0.f;
            for (int j = 0; j < 16; ++j) a += km[j * 128 + d] * __expf(lg * (float)(15 - j)) * vm[j * 128 + e];
            S[idx] = a; }
    } else {
        const float* sr = F.in[3] + ((size_t)(stream - NBP) * NH + head) * DH * DH;
        for (int idx = tid; idx < 16384; idx += 512) S[idx] = sr[idx];
    }
    LDS_WAIT(); __syncthreads();
    const int nchunk = pr ? SEQ / 64 : 1;
    for (int ch = 0; ch < nchunk; ++ch) {
        const int row0 = pr ? stream * SEQ + ch * 64 : MP + (stream - NBP) * 64;
        for (int x = tid; x < 1024; x += 512) { const int i = x >> 4, c8 = (x & 15) * 8; const size_t g = (size_t)(row0 + i) * 512 + head * 128 + c8;
            *(LAS v4u*)(qs + i * 128 + c8) = *(const GAS v4u*)(Q + g); *(LAS v4u*)(ks + i * 128 + c8) = *(const GAS v4u*)(Kb + g); *(LAS v4u*)(vs + i * 128 + c8) = *(const GAS v4u*)(V + g); }
        LDS_WAIT(); __syncthreads();
        { const int i = tid >> 3, jg = tid & 7;
            for (int jj = 0; jj < 8; ++jj) { const int j = 8 * jg + jj; float a = 0.f;
                if (j <= i) { for (int d = 0; d < 128; ++d) a += bf2f(qs[i * 128 + d]) * bf2f(ks[j * 128 + d]); a *= __expf(lg * (float)(i - j)); }
                sc[i * 64 + j] = a; } }
        LDS_WAIT(); __syncthreads();
        { const int i = tid >> 3, eg = tid & 7, e0 = 16 * eg; float acc[16];
#pragma unroll
            for (int e = 0; e < 16; ++e) acc[e] = 0.f;
            for (int j = 0; j <= i; ++j) { const float s = sc[i * 64 + j];
#pragma unroll
                for (int e = 0; e < 16; ++e) acc[e] += s * bf2f(vs[j * 128 + e0 + e]); }
            const float cd = __expf(lg * (float)(i + 1));
            for (int d = 0; d < 128; ++d) { const float qd = bf2f(qs[i * 128 + d]) * cd;
#pragma unroll
                for (int e = 0; e < 16; ++e) acc[e] += qd * S[d * 128 + e0 + e]; }
            float sum = 0.f;
#pragma unroll
            for (int e = 0; e < 16; ++e) sum += acc[e];
            sum += __shfl_xor(sum, 1); sum += __shfl_xor(sum, 2); sum += __shfl_xor(sum, 4);
            const float mu = sum * (1.0f / 128.0f); float var = 0.f;
#pragma unroll
            for (int e = 0; e < 16; ++e) { const float dd = acc[e] - mu; var += dd * dd; }
            var += __shfl_xor(var, 1); var += __shfl_xor(var, 2); var += __shfl_xor(var, 4);
            const float rsd = 1.0f / sqrtf(var * (1.0f / 128.0f) + GN_EPS);
            const size_t r = (size_t)(row0 + i);
#pragma unroll
            for (int e = 0; e < 16; e += 2) { const int cc = head * 128 + e0 + e;
                const float o0 = (acc[e] - mu) * rsd * gnw[cc] * bf2f(SG[r * 512 + cc]), o1 = (acc[e + 1] - mu) * rsd * gnw[cc + 1] * bf2f(SG[r * 512 + cc + 1]);
                *(GAS unsigned*)(MIXO + r * DM + 512 + cc) = pk2(o0, o1); } }
        __syncthreads();
        { const int d = tid >> 2, e0 = 32 * (tid & 3); float acc[32]; const float g64 = __expf(lg * 64.0f);
#pragma unroll
            for (int e = 0; e < 32; ++e) acc[e] = g64 * S[d * 128 + e0 + e];
            for (int j = 0; j < 64; ++j) { const float kd = bf2f(ks[j * 128 + d]) * __expf(lg * (float)(63 - j));
#pragma unroll
                for (int e = 0; e < 32; ++e) acc[e] += kd * bf2f(vs[j * 128 + e0 + e]); }
#pragma unroll
            for (int e = 0; e < 32; ++e) S[d * 128 + e0 + e] = acc[e]; }
        LDS_WAIT(); __syncthreads();
    }
    float* dst = pr ? retp + ((size_t)stream * NH + head) * DH * DH : rets + ((size_t)(stream - NBP) * NH + head) * DH * DH;
    for (int idx = tid; idx < 16384; idx += 512) dst[idx] = S[idx];
    __syncthreads();
}

#endif
__device__ __forceinline__ void scan_phase(Frame& F) {
    const f32x4* TG = (const f32x4*)(F.ws + WS_TG); f32x4* GG = (f32x4*)(F.ws + WS_GG); const f32x4* SM = (const f32x4*)(F.ws + WS_SMETA);
    const int nthr = F.G * NWAVES * 64;
    for (int x = F.vcu * NWAVES * 64 + F.tid; x < 16 * 4096; x += nthr) { const int bh = x >> 12, f4 = x & 4095, h = bh & 3;
        const float g512 = exp2f(log2f(1.0f - exp2f(-5.0f - (float)h)) * 512.0f);
        f32x4 t[16];
#pragma unroll
        for (int g = 0; g < 16; ++g) t[g] = TG[(size_t)(bh * 16 + g) * 4096 + f4];
        f32x4 G = SM[(size_t)h * 4096 + f4];
#pragma unroll
        for (int g = 0; g < 16; ++g) { GG[(size_t)(bh * 16 + g) * 4096 + f4] = G; G = G * g512 + t[g]; } }
}
__device__ __forceinline__ void final_norm(Frame& F) {
    const float* wf = F.in[13]; const float* part = (const float*)(F.ws + WS_PART); const bool split = (F.G == 256);
    const int gw = F.vcu * NWAVES + F.wave, NGW = F.G * NWAVES;
    f32x4 wv[4];
#pragma unroll
    for (int j = 0; j < 4; ++j) wv[j] = *(const f32x4*)(wf + 4 * (F.lane + 64 * j));
    for (int m = gw; m < M; m += NGW) {
        GAS f32x4* p = (GAS f32x4*)(F.out + (size_t)m * DM) + F.lane; f32x4 v[4];
#pragma unroll
        for (int j = 0; j < 4; ++j) v[j] = p[64 * j];
        if (split && m >= MP) {
#pragma unroll
            for (int kp = 0; kp < 8; ++kp) { const GAS f32x4* q = (const GAS f32x4*)(part + ((size_t)kp * MS + (m - MP)) * DM) + F.lane;
#pragma unroll
                for (int j = 0; j < 4; ++j) v[j] = v[j] + q[64 * j]; } }
        float s = 0.f;
#pragma unroll
        for (int j = 0; j < 4; ++j) s += (v[j].x * v[j].x + v[j].y * v[j].y) + (v[j].z * v[j].z + v[j].w * v[j].w);
        const float rs = 1.0f / sqrtf(wave_sum(s) * (1.0f / DM) + NORM_EPS);
#pragma unroll
        for (int j = 0; j < 4; ++j) p[64 * j] = v[j] * rs * wv[j];
    }
}

constexpr int N_PHASES = 9;
struct Args { const float* in[14]; float* out; unsigned char* ws; int ph_lo, ph_hi; };
static_assert(sizeof(Args) == 14 * 8 + 8 + 8 + 8, "Args has no padding");
__global__ void __launch_bounds__(NWAVES * 64, 2) mk_fwd(Args args) {
    extern __shared__ __attribute__((aligned(16))) unsigned char lds[];
    Frame F;
    F.lds = (LAS unsigned char*)lds;
    F.MISC = (volatile LAS unsigned*)(F.lds + MISC_OFF);
    F.tid = threadIdx.x; F.lane = F.tid & 63; F.wave = __builtin_amdgcn_readfirstlane(F.tid >> 6);
    F.G = gridDim.x; { const int bx = blockIdx.x; F.vcu = (F.G % 8 == 0) ? (bx % 8) * (F.G / 8) + bx / 8 : bx; }
    F.ws = args.ws; F.out = args.out; F.ctl = (gu32*)(args.ws + WS_CTL);
#pragma unroll
    for (int i = 0; i < 14; ++i) F.in[i] = args.in[i];
    for (int u = F.tid; u < (LDS_BYTES - LDSCTL_OFF) / 4; u += NWAVES * 64) ((LAS unsigned*)(F.lds + LDSCTL_OFF))[u] = 0u;
    __syncthreads();
    const int lo = args.ph_lo, hi = args.ph_hi;
    const bool one_launch = (lo == 0 && hi == N_PHASES);
    XcdBarrier bar; bar.bar = (unsigned*)(F.ctl + CW_BAR); bar.x = 0; bar.st = nullptr;
    if (one_launch) bar = xcd_barrier_post((unsigned*)(F.ctl + CW_BAR), F.MISC + 8);
#define IN(k) (lo <= (k) && (k) < hi)
#ifndef PROBE_DUP
#define PROBE_DUP 0
#endif
#define REP(k) for (int rep_ = 0; rep_ < (((PROBE_DUP >> (k)) & 1) ? 2 : 1); ++rep_)
#define SEAM(k) do { if (IN(k) && IN((k) + 1)) xcd_barrier(bar); } while (0)

    REP(0) if (IN(0)) { p0_prologue(F); } SEAM(0);
    if (IN(1)) {
        pg8::Gemm g{(const pg8::bf16_t*)(F.ws + WS_XB), (const pg8::bf16_t*)(F.ws + WS_WIN), M, DIN, DM}; pg8::StaticOrder S; S.init(M, DIN, F.G, (int)blockIdx.x, DM / 64);
        pg8::EpiIn E{(pg8::bf16_t*)(F.ws + WS_U), (const float*)(F.ws + WS_RSTD1), (const float*)(F.ws + WS_ROPE)};
        pg8::gemm_phase<pg8::EpiIn, pg8::StaticOrder, true, true>(F.lds + RING_OFF, g, S, E);
        meta_proj(F);
    } SEAM(1);
    {
    if (IN(2)) {
        REP(8) conv_phase(F);
        REP(9) for (int t = blockIdx.x; t < 260; t += F.G) {
            if (t < 256) { const int bh = t >> 4, g = t & 15; ret::ret_task<false>(F, (bh >> 2) * SEQ + g * 512, 8, bh & 3, nullptr, nullptr, (float*)(F.ws + WS_TG) + (size_t)t * 16384, nullptr); }
            else ret::smeta_task(F, t - 256, (float*)(F.ws + WS_SMETA) + (size_t)(t - 256) * 16384);
        }
    } SEAM(2);
    REP(3) if (IN(3)) { scan_phase(F); } SEAM(3);
    if (IN(4)) {
        REP(4) for (int t = blockIdx.x; t < 384; t += F.G) {
            int row0, nch, head; const float* sn = nullptr; const float* sd = nullptr; float* od = nullptr;
            if (t < 256) { const int bh = t >> 4, g = t & 15; row0 = (bh >> 2) * SEQ + g * 512; nch = 8; head = bh & 3; sn = (const float*)(F.ws + WS_GG) + (size_t)t * 16384; if (g == 15) od = F.out + O_RETP + (size_t)bh * 16384; }
            else { const int sh = t - 256; row0 = MP + (sh >> 2) * 64; nch = 1; head = sh & 3; sd = F.in[3] + (size_t)sh * 16384; od = F.out + O_RETS + (size_t)sh * 16384; }
            ret::ret_task<true>(F, row0, nch, head, sn, sd, nullptr, od);
        }
#if RET_ORACLE

#endif
    } SEAM(4);
    }
    if (IN(5)) {
        pg8::Gemm g{(const pg8::bf16_t*)(F.ws + WS_MIX), (const pg8::bf16_t*)(F.ws + WS_WOUT), M, DM, DM}; pg8::StaticOrder S; S.init(M, DM, F.G, (int)blockIdx.x, DM / 64);
        pg8::EpiOut E{F.in[0], F.in[1], F.out + O_Y, (pg8::bf16_t*)(F.ws + WS_XB), (float*)(F.ws + WS_SSQ1)};
        pg8::gemm_phase<pg8::EpiOut, pg8::StaticOrder, true, true>(F.lds + RING_OFF, g, S, E);
    } SEAM(5);
    if (IN(6)) {
        pg8::Gemm g{(const pg8::bf16_t*)(F.ws + WS_XB), (const pg8::bf16_t*)(F.ws + WS_WUP), M, DFF, DM}; pg8::StaticOrder S; S.init(M, DFF, F.G, (int)blockIdx.x, DM / 64);
        pg8::EpiUp E{(pg8::bf16_t*)(F.ws + WS_ACT), (const float*)(F.ws + WS_SSQ1), NORM_EPS};
        pg8::gemm_phase<pg8::EpiUp, pg8::StaticOrder, true, true>(F.lds + RING_OFF, g, S, E);
    } SEAM(6);
    if (IN(7)) {
        pg8::Gemm g{(const pg8::bf16_t*)(F.ws + WS_ACT), (const pg8::bf16_t*)(F.ws + WS_WDN), M, DM, DFF}; pg8::SplitOrder S; S.init(M, MP, DM, F.G, (int)blockIdx.x, DFF / 64);
        pg8::EpiDown E{F.out + O_Y, (float*)(F.ws + WS_PART)};
        pg8::gemm_phase<pg8::EpiDown, pg8::SplitOrder, true, true>(F.lds + RING_OFF, g, S, E);
    } SEAM(7);
    if (IN(8)) { final_norm(F); }
#undef IN
#undef SEAM
}

#ifndef MK_ONE_LAUNCH
#define MK_ONE_LAUNCH 1
#endif
extern "C" void kernel_launch(void* const* d_in, const int* in_sizes, int n_in, void* d_out, int out_size, void* d_ws, size_t ws_size, hipStream_t stream) {
    static int grid = 0;
    if (grid == 0) {
        if (n_in != 14 || in_sizes[0] != MP * DM || in_sizes[1] != MS * DM || (size_t)out_size != O_END || ws_size < WS_END) {
            fprintf(stderr, "kernel_launch: unexpected shapes: n_in %d in0 %d in1 %d out %d ws %zu (need %zu); nothing launched\n", n_in, n_in > 0 ? in_sizes[0] : -1, n_in > 1 ? in_sizes[1] : -1, out_size, ws_size, (size_t)WS_END); grid = -1; return; }
        int dev = 0, cus = 0;
        if (hipGetDevice(&dev) != hipSuccess || hipDeviceGetAttribute(&cus, hipDeviceAttributeMultiprocessorCount, dev) != hipSuccess) { fprintf(stderr, "kernel_launch: device query failed\n"); grid = -1; return; }
        if (hipFuncSetAttribute((const void*)mk_fwd, hipFuncAttributeMaxDynamicSharedMemorySize, LDS_BYTES) != hipSuccess) { fprintf(stderr, "kernel_launch: hipFuncSetAttribute failed\n"); grid = -1; return; }
        int per_cu = 0;
        if (hipOccupancyMaxActiveBlocksPerMultiprocessor(&per_cu, (const void*)mk_fwd, NWAVES * 64, LDS_BYTES) != hipSuccess || per_cu < 1) fprintf(stderr, "kernel_launch: occupancy query says %d per CU\n", per_cu);
        (void)hipGetLastError();
        grid = cus;
    }
    if (grid < 0) return;
    if (hipMemsetAsync((char*)d_ws + WS_CTL, 0, CTL_ZERO_BYTES, stream) != hipSuccess) { fprintf(stderr, "kernel_launch: memset failed\n"); return; }
    Args a{};
    for (int i = 0; i < 14; ++i) a.in[i] = (const float*)d_in[i];
    a.out = (float*)d_out; a.ws = (unsigned char*)d_ws;
#if MK_ONE_LAUNCH
    a.ph_lo = 0; a.ph_hi = N_PHASES;
    hipLaunchKernelGGL(mk_fwd, dim3(grid), dim3(NWAVES * 64), LDS_BYTES, stream, a);
#else
    for (int p = 0; p < N_PHASES; ++p) { a.ph_lo = p; a.ph_hi = p + 1; hipLaunchKernelGGL(mk_fwd, dim3(grid), dim3(NWAVES * 64), LDS_BYTES, stream, a); }
#endif
    const hipError_t le = hipPeekAtLastError();
    if (le != hipSuccess) fprintf(stderr, "kernel_launch: launch failed: %s\n", hipGetErrorName(le));
}
```

```cpp
#include <hip/hip_runtime.h>
#include <cstdio>
#include <cstdint>
#ifndef RET_ORACLE
#define RET_ORACLE 0
#endif
namespace pg8 {
#define PG8_LAS __attribute__((address_space(3)))
typedef unsigned short bf16_t;
typedef short bf16x8 __attribute__((ext_vector_type(8)));
typedef float f32x4 __attribute__((ext_vector_type(4)));
typedef unsigned u32x4 __attribute__((ext_vector_type(4)));
constexpr int BM = 256, BK = 64, HALF = 128, HTB = HALF * BK * 2  , STAGE_BYTES = 8 * HTB, NXCD = 8, WGM = 8;

__host__ __device__ __forceinline__ int lds_byte(int r, int c) { const int st = (r >> 4) * 2 + (c >> 5), rr = r & 15, cc = c & 31, ob = rr * 64 + cc * 2; return st * 1024 + (ob ^ (((ob >> 9) & 1) << 5)); }
__host__ __device__ __forceinline__ void stage_rc(int b, int& R, int& C) { const int st = b / 1024, sb = b % 1024, swz = sb ^ (((sb >> 9) & 1) << 5); R = (st >> 1) * 16 + swz / 64; C = (st & 1) * 32 + (swz % 64) / 2; }
__host__ __device__ __forceinline__ int perm32(int rho) { const int n = rho >> 4, i = rho & 15; return 8 * (i >> 2) + 4 * n + (i & 3); }

struct Unit { int pm, pn, kt0, ntu, kind; };
struct Gemm { const bf16_t* A; const bf16_t* Bt; int M, N, K; };

struct StaticOrder {
    int nM, nN, nwg, G, c, ntk;
    __host__ __device__ void init(int M, int N, int G_, int c_, int ntk_) { nM = M / BM; nN = N / BM; nwg = nM * nN; G = G_; c = c_; ntk = ntk_; }
    __host__ __device__ bool next(int i, Unit& u) const {
        const long L = (long)i * G + c; if (L >= nwg) return false;
        int wgid = (int)L; { const int q = nwg / NXCD, r = nwg % NXCD, xcd = wgid % NXCD, off = wgid / NXCD; wgid = (xcd < r ? xcd * (q + 1) : r * (q + 1) + (xcd - r) * q) + off; }
        const int nig = WGM * nN, gid = wgid / nig, fm = gid * WGM, gsz = (nM - fm) < WGM ? (nM - fm) : WGM;
        u.pm = fm + ((wgid % nig) % gsz); u.pn = (wgid % nig) / gsz; u.kt0 = 0; u.ntu = ntk; u.kind = 0; return true;
    }
    __device__ __forceinline__ void a_ready(const Unit&) const {}
    __device__ __forceinline__ void done(const Unit&) const {}
};
struct SplitOrder {
    StaticOrder so; int c, ntk; bool split;
    __host__ __device__ void init(int M, int Mfull, int N, int G_, int c_, int ntk_) { split = (G_ == 256 && N == 4 * BM && (M - Mfull) == 8 * BM && ntk_ % 16 == 0); so.init(split ? Mfull : M, N, G_, c_, ntk_); c = c_; ntk = ntk_; }
    __host__ __device__ bool next(int i, Unit& u) const {
        const bool piece = split && i >= 2; Unit t; const bool ok = so.next(piece ? 0 : i, t);
        const int kp = c & 7, idx = c >> 3, pl = ntk / 8;
        u.pm = piece ? so.nM + (idx & 7) : t.pm; u.pn = piece ? (idx >> 3) : t.pn; u.kt0 = piece ? kp * pl : 0; u.ntu = piece ? pl : ntk; u.kind = piece ? 1 : 0;
        return piece ? (i == 2) : ok;
    }
    __device__ __forceinline__ void a_ready(const Unit&) const {}
    __device__ __forceinline__ void done(const Unit&) const {}
};

__device__ __forceinline__ unsigned cvt_pk_bf16(float lo, float hi) { unsigned r; asm volatile("v_cvt_pk_bf16_f32 %0, %1, %2" : "=v"(r) : "v"(lo), "v"(hi)); return r; }
typedef float f32x2 __attribute__((ext_vector_type(2)));
typedef float f32x2v __attribute__((ext_vector_type(2)));
typedef unsigned u32x2 __attribute__((ext_vector_type(2)));
constexpr int ROWS_P = 32768;
__device__ __forceinline__ int row_pos(int r) { return r < ROWS_P ? (r & 8191) : 2048 + (r & 63); }
__device__ __forceinline__ float silu_f(float x) { return x * __builtin_amdgcn_rcpf(1.0f + __builtin_amdgcn_exp2f(-1.4426950408889634f * x)); }

struct EpiIn {
    static constexpr bool PERM = true, AFTER_DRAIN = false;
    bf16_t* base; const float* rstd; const float* rope;
    static constexpr size_t REG = (size_t)34816 * 512;
    __device__ __forceinline__ void operator()(const f32x4 (&acc)[2][2][4][2], const Unit& u, int wr, int wc, int fr, int fq) const {
        const int pn = u.pn, lc0 = wc * 32 + 8 * fq;
        const int rbase = u.pm * BM + wr * 64 + fr;
        if (pn < 4) {
#pragma unroll
            for (int ai = 0; ai < 2; ++ai)
#pragma unroll
                for (int m = 0; m < 4; ++m) { const int r = rbase + ai * HALF + m * 16; const float rs = rstd[r], rs2 = rs * rs;
                    const f32x4 a0 = acc[ai][0][m][0] * acc[ai][1][m][0] * rs2, a1 = acc[ai][0][m][1] * acc[ai][1][m][1] * rs2;
                    u32x4 w; w.x = cvt_pk_bf16(a0[0], a0[1]); w.y = cvt_pk_bf16(a0[2], a0[3]); w.z = cvt_pk_bf16(a1[0], a1[1]); w.w = cvt_pk_bf16(a1[2], a1[3]);
                    *(u32x4*)(base + (size_t)r * 512 + pn * 128 + lc0) = w; }
        } else if (pn >= 6 && pn < 10) {
            bf16_t* dst = base + (size_t)(2 + ((pn - 6) >> 1)) * REG; const int head = 2 * ((pn - 6) & 1) + (lc0 >> 6), i0 = lc0 & 63;
#pragma unroll
            for (int ai = 0; ai < 2; ++ai)
#pragma unroll
                for (int m = 0; m < 4; ++m) { const int r = rbase + ai * HALF + m * 16; const float rs = rstd[r];
                    const f32x4* cs = (const f32x4*)(rope + ((size_t)row_pos(r) * 64 + i0) * 2);
                    const f32x4 c0 = cs[0], c1 = cs[1], c2 = cs[2], c3 = cs[3];
                    const f32x4 x1a = acc[ai][0][m][0] * rs, x1b = acc[ai][0][m][1] * rs, x2a = acc[ai][1][m][0] * rs, x2b = acc[ai][1][m][1] * rs;
                    float o1[8], o2[8];
                    o1[0] = x1a[0] * c0[0] - x2a[0] * c0[1]; o2[0] = x1a[0] * c0[1] + x2a[0] * c0[0];
                    o1[1] = x1a[1] * c0[2] - x2a[1] * c0[3]; o2[1] = x1a[1] * c0[3] + x2a[1] * c0[2];
                    o1[2] = x1a[2] * c1[0] - x2a[2] * c1[1]; o2[2] = x1a[2] * c1[1] + x2a[2] * c1[0];
                    o1[3] = x1a[3] * c1[2] - x2a[3] * c1[3]; o2[3] = x1a[3] * c1[3] + x2a[3] * c1[2];
                    o1[4] = x1b[0] * c2[0] - x2b[0] * c2[1]; o2[4] = x1b[0] * c2[1] + x2b[0] * c2[0];
                    o1[5] = x1b[1] * c2[2] - x2b[1] * c2[3]; o2[5] = x1b[1] * c2[3] + x2b[1] * c2[2];
                    o1[6] = x1b[2] * c3[0] - x2b[2] * c3[1]; o2[6] = x1b[2] * c3[1] + x2b[2] * c3[0];
                    o1[7] = x1b[3] * c3[2] - x2b[3] * c3[3]; o2[7] = x1b[3] * c3[3] + x2b[3] * c3[2];
                    u32x4 w1, w2; w1.x = cvt_pk_bf16(o1[0], o1[1]); w1.y = cvt_pk_bf16(o1[2], o1[3]); w1.z = cvt_pk_bf16(o1[4], o1[5]); w1.w = cvt_pk_bf16(o1[6], o1[7]);
                    w2.x = cvt_pk_bf16(o2[0], o2[1]); w2.y = cvt_pk_bf16(o2[2], o2[3]); w2.z = cvt_pk_bf16(o2[4], o2[5]); w2.w = cvt_pk_bf16(o2[6], o2[7]);
                    bf16_t* p = dst + (size_t)r * 512 + head * 128 + i0;
                    *(u32x4*)p = w1; *(u32x4*)(p + 64) = w2; }
        } else {
            const int reg = (pn < 6) ? 1 : (pn < 12 ? 4 : 5); bf16_t* dst = base + (size_t)reg * REG; const int cb = (pn & 1) * 256; const bool act = pn >= 12;
#pragma unroll
            for (int ai = 0; ai < 2; ++ai)
#pragma unroll
                for (int m = 0; m < 4; ++m) { const int r = rbase + ai * HALF + m * 16; const float rs = rstd[r];
#pragma unroll
                    for (int bj = 0; bj < 2; ++bj) { f32x4 v0 = acc[ai][bj][m][0] * rs, v1 = acc[ai][bj][m][1] * rs;
                        if (act) { v0 = (f32x4){silu_f(v0[0]), silu_f(v0[1]), silu_f(v0[2]), silu_f(v0[3])}; v1 = (f32x4){silu_f(v1[0]), silu_f(v1[1]), silu_f(v1[2]), silu_f(v1[3])}; }
                        u32x4 w; w.x = cvt_pk_bf16(v0[0], v0[1]); w.y = cvt_pk_bf16(v0[2], v0[3]); w.z = cvt_pk_bf16(v1[0], v1[1]); w.w = cvt_pk_bf16(v1[2], v1[3]);
                        *(u32x4*)(dst + (size_t)r * 512 + cb + bj * HALF + lc0) = w; } }
        }
    }
};

struct EpiOut {
    static constexpr bool PERM = false, AFTER_DRAIN = false;
    const float* xp; const float* xs; bf16_t* Hb; float* ssq;
    __device__ __forceinline__ void operator()(const f32x4 (&acc)[2][2][4][2], const Unit& u, int wr, int wc, int fr, int fq) const {
        const int rbase = u.pm * BM + wr * 64 + fr, col0 = u.pn * BM + wc * 32 + 4 * fq;
#pragma unroll
        for (int ai = 0; ai < 2; ++ai)
#pragma unroll
            for (int m = 0; m < 4; ++m) { const int r = rbase + ai * HALF + m * 16;
                const float* xrow = (r < ROWS_P) ? xp + (size_t)r * 1024 : xs + (size_t)(r - ROWS_P) * 1024;
                float s = 0.f;
#pragma unroll
                for (int bj = 0; bj < 2; ++bj)
#pragma unroll
                    for (int n = 0; n < 2; ++n) { const int c = col0 + bj * HALF + n * 16; const f32x4 h = *(const f32x4*)(xrow + c) + acc[ai][bj][m][n];
                        u32x2 w; w.x = cvt_pk_bf16(h[0], h[1]); w.y = cvt_pk_bf16(h[2], h[3]);
                        *(u32x2*)(Hb + (size_t)r * 1024 + c) = w; s += (h[0] * h[0] + h[1] * h[1]) + (h[2] * h[2] + h[3] * h[3]); }
                s += __shfl_xor(s, 16); s += __shfl_xor(s, 32);
                if (fq == 0) ssq[(size_t)r * 16 + u.pn * 4 + wc] = s; }
    }
};

struct EpiUp {
    static constexpr bool PERM = true, AFTER_DRAIN = false;
    bf16_t* ACT; const float* ssq; float eps;
    __device__ __forceinline__ void operator()(const f32x4 (&acc)[2][2][4][2], const Unit& u, int wr, int wc, int fr, int fq) const {
        const int rbase = u.pm * BM + wr * 64 + fr, col0 = u.pn * BM + wc * 32 + 8 * fq;
#pragma unroll
        for (int ai = 0; ai < 2; ++ai)
#pragma unroll
            for (int m = 0; m < 4; ++m) { const int r = rbase + ai * HALF + m * 16;
                const f32x4 p = *(const f32x4*)(ssq + (size_t)r * 16 + 4 * fq); float s = (p[0] + p[1]) + (p[2] + p[3]);
                s += __shfl_xor(s, 16); s += __shfl_xor(s, 32);
                const float rs = __builtin_amdgcn_rsqf(s * (1.0f / 1024.0f) + eps);
#pragma unroll
                for (int bj = 0; bj < 2; ++bj) { f32x4 v0 = acc[ai][bj][m][0] * rs, v1 = acc[ai][bj][m][1] * rs;
#pragma unroll
                    for (int j = 0; j < 4; ++j) { const float a = fmaxf(v0[j], 0.f), b = fmaxf(v1[j], 0.f); v0[j] = a * a; v1[j] = b * b; }
                    u32x4 w; w.x = cvt_pk_bf16(v0[0], v0[1]); w.y = cvt_pk_bf16(v0[2], v0[3]); w.z = cvt_pk_bf16(v1[0], v1[1]); w.w = cvt_pk_bf16(v1[2], v1[3]);
                    *(u32x4*)(ACT + (size_t)r * 4096 + col0 + bj * HALF) = w; } }
    }
};

struct EpiDown {
    static constexpr bool PERM = false, AFTER_DRAIN = false;
    float* out; float* part; const bf16_t* Hb;
    __device__ __forceinline__ void operator()(const f32x4 (&acc)[2][2][4][2], const Unit& u, int wr, int wc, int fr, int fq) const {
        const int rbase = u.pm * BM + wr * 64 + fr, col0 = u.pn * BM + wc * 32 + 4 * fq;
        if (u.kind == 0) {
#pragma unroll
            for (int ai = 0; ai < 2; ++ai)
#pragma unroll
                for (int m = 0; m < 4; ++m) { const int r = rbase + ai * HALF + m * 16;
#pragma unroll
                    for (int bj = 0; bj < 2; ++bj)
#pragma unroll
                        for (int n = 0; n < 2; ++n) { const size_t o = (size_t)r * 1024 + col0 + bj * HALF + n * 16; const u32x2 hb = *(const u32x2*)(Hb + o);
                            const f32x4 h = (f32x4){__builtin_bit_cast(float, hb.x << 16), __builtin_bit_cast(float, hb.x & 0xffff0000u), __builtin_bit_cast(float, hb.y << 16), __builtin_bit_cast(float, hb.y & 0xffff0000u)};
                            *(f32x4*)(out + o) = h + acc[ai][bj][m][n]; } }
        } else {
            float* pb = part + (size_t)(u.kt0 / u.ntu) * (2048 * 1024);
#pragma unroll
            for (int ai = 0; ai < 2; ++ai)
#pragma unroll
                for (int m = 0; m < 4; ++m) { const int r = rbase + ai * HALF + m * 16 - ROWS_P;
#pragma unroll
                    for (int bj = 0; bj < 2; ++bj)
#pragma unroll
                        for (int n = 0; n < 2; ++n) *(f32x4*)(pb + (size_t)r * 1024 + col0 + bj * HALF + n * 16) = acc[ai][bj][m][n]; }
        }
    }
};
template <class Epi, class Sched, bool ALIGN_EPI = false, bool SP2 = false>
__device__ __forceinline__ void gemm_phase(PG8_LAS unsigned char* lds, const Gemm g, const Sched& S, const Epi& E) {
    const int tid = threadIdx.x, wid = __builtin_amdgcn_readfirstlane(tid >> 6), lane = tid & 63, wr = wid >> 2, wc = wid & 3, fr = lane & 15, fq = lane >> 4;
    const int K = g.K;
    unsigned voffA[2], voffB[2];
#pragma unroll
    for (int i = 0; i < 2; ++i) { int R, C; stage_rc(tid * 16 + i * 8192, R, C); const int Rb = Epi::PERM ? ((R & ~31) + perm32(R & 31)) : R;
        voffA[i] = (unsigned)(R * K + C) * 2u; voffB[i] = (unsigned)(Rb * K + C) * 2u; }
    const size_t kstep = (size_t)(BK * 2);
    const size_t hstep = (size_t)HALF * K * 2;
    const size_t tstep = 2 * hstep;
    const unsigned ldsw = (unsigned)wid * 1024u;
    const int aoff = lds_byte(wr * 64 + fr, fq * 8), boff = lds_byte(wc * 32 + fr, fq * 8);
#define PG8_SA(b, h) (((b) * 2 + (h)) * HTB)
#define PG8_SB(b, h) ((4 + (b) * 2 + (h)) * HTB)
#define PG8_STAGE(bufoff, gbase, voff) do { _Pragma("unroll") for (int _i = 0; _i < 2; ++_i) \
        __builtin_amdgcn_global_load_lds((const unsigned*)((const char*)(gbase) + (voff)[_i]), (PG8_LAS unsigned*)(lds + (bufoff) + ldsw + _i * 8192), 16, 0, 0); } while (0)
#define PG8_LDA(dst, b, h) do { _Pragma("unroll") for (int m = 0; m < 4; ++m) _Pragma("unroll") for (int k = 0; k < 2; ++k) dst[m][k] = *(const PG8_LAS bf16x8*)(lds + PG8_SA(b, h) + aoff + m * 2048 + k * 1024); } while (0)
#define PG8_LDB(dst, b, h) do { _Pragma("unroll") for (int n = 0; n < 2; ++n) _Pragma("unroll") for (int k = 0; k < 2; ++k) dst[n][k] = *(const PG8_LAS bf16x8*)(lds + PG8_SB(b, h) + boff + n * 2048 + k * 1024); } while (0)
#define PG8_MMA(ai, bj, At, Bt) do { __builtin_amdgcn_s_setprio(1); _Pragma("unroll") for (int m = 0; m < 4; ++m) _Pragma("unroll") for (int n = 0; n < 2; ++n) _Pragma("unroll") for (int k = 0; k < 2; ++k) \
        acc[ai][bj][m][n] = __builtin_amdgcn_mfma_f32_16x16x32_bf16(Bt[n][k], At[m][k], acc[ai][bj][m][n], 0, 0, 0); __builtin_amdgcn_s_setprio(0); } while (0)
#define PG8_WAIT_V(n) asm volatile("s_waitcnt vmcnt(" #n ")" ::: "memory")
#define PG8_WAIT_L(n) asm volatile("s_waitcnt lgkmcnt(" #n ")" ::: "memory")
#define PG8_BAR __builtin_amdgcn_s_barrier()
#define PG8_SCHED __builtin_amdgcn_sched_barrier(0)
    Unit cur, nxt; int ui = 0;
    if (!S.next(0, cur)) return;
    f32x4 acc[2][2][4][2];
#pragma unroll
    for (int a = 0; a < 2; ++a)
#pragma unroll
        for (int b = 0; b < 2; ++b)
#pragma unroll
            for (int m = 0; m < 4; ++m)
#pragma unroll
                for (int n = 0; n < 2; ++n) acc[a][b][m][n] = (f32x4){0.f, 0.f, 0.f, 0.f};
    bf16x8 At[4][2], B0[2][2], B1[2][2];
    const char* cA = (const char*)g.A + (size_t)cur.pm * tstep + (size_t)cur.kt0 * kstep; const char* cB = (const char*)g.Bt + (size_t)cur.pn * tstep + (size_t)cur.kt0 * kstep;
    S.a_ready(cur);
    if constexpr (SP2) {
        PG8_STAGE(PG8_SB(0, 0), cB, voffB); PG8_STAGE(PG8_SB(0, 1), cB + hstep, voffB); PG8_STAGE(PG8_SA(0, 0), cA, voffA); PG8_STAGE(PG8_SA(0, 1), cA + hstep, voffA);
        if (wr == 1) PG8_BAR;
        PG8_WAIT_V(2); PG8_BAR;
        PG8_STAGE(PG8_SB(1, 0), cB + kstep, voffB); PG8_STAGE(PG8_SA(1, 0), cA + kstep, voffA); PG8_STAGE(PG8_SB(1, 1), cB + hstep + kstep, voffB);
        PG8_WAIT_V(6); PG8_BAR;
    } else {
        PG8_STAGE(PG8_SB(0, 0), cB, voffB); PG8_STAGE(PG8_SA(0, 0), cA, voffA); PG8_STAGE(PG8_SB(0, 1), cB + hstep, voffB); PG8_STAGE(PG8_SA(0, 1), cA + hstep, voffA);
        if (wr == 1) PG8_BAR;
        PG8_WAIT_V(4); PG8_BAR;
        PG8_STAGE(PG8_SB(1, 0), cB + kstep, voffB); PG8_STAGE(PG8_SA(1, 0), cA + kstep, voffA); PG8_STAGE(PG8_SB(1, 1), cB + hstep + kstep, voffB);
        PG8_WAIT_V(6); PG8_BAR;
    }
    for (;;) {
        const bool has_next = S.next(ui + 1, nxt);
        const char* nA = has_next ? (const char*)g.A + (size_t)nxt.pm * tstep + (size_t)nxt.kt0 * kstep : cA; const char* nB = has_next ? (const char*)g.Bt + (size_t)nxt.pn * tstep + (size_t)nxt.kt0 * kstep : cB;
        const int nt = cur.ntu;
        for (int t = 0; t < nt; t += 2) {
            const bool last = (t == nt - 2);
            const char* a1 = cA + (size_t)(t + 1) * kstep;
            const char* a2 = last ? nA : cA + (size_t)(t + 2) * kstep; const char* b2 = last ? nB : cB + (size_t)(t + 2) * kstep;
            const char* a3 = a2 + kstep; const char* b3 = b2 + kstep;
            if (last && has_next) S.a_ready(nxt);
            if constexpr (SP2) {
            PG8_LDB(B0, 0, 0); PG8_LDB(B1, 0, 1); PG8_SCHED; PG8_LDA(At, 0, 0); PG8_STAGE(PG8_SA(1, 1), a1 + hstep, voffA);
            PG8_WAIT_V(8); PG8_WAIT_L(0); PG8_BAR; PG8_MMA(0, 0, At, B0); PG8_MMA(0, 1, At, B1); PG8_BAR; PG8_SCHED;
            PG8_LDA(At, 0, 1); PG8_STAGE(PG8_SB(0, 0), b2, voffB); PG8_STAGE(PG8_SB(0, 1), b2 + hstep, voffB); PG8_STAGE(PG8_SA(0, 0), a2, voffA);
            PG8_WAIT_V(8); PG8_WAIT_L(0); PG8_BAR; PG8_MMA(1, 0, At, B0); PG8_MMA(1, 1, At, B1); PG8_BAR; PG8_SCHED;
            PG8_LDB(B0, 1, 0); PG8_LDB(B1, 1, 1); PG8_SCHED; PG8_LDA(At, 1, 0); PG8_STAGE(PG8_SA(0, 1), a2 + hstep, voffA);
            PG8_WAIT_V(8); PG8_WAIT_L(0); PG8_BAR; PG8_MMA(0, 0, At, B0); PG8_MMA(0, 1, At, B1); PG8_BAR; PG8_SCHED;
            PG8_LDA(At, 1, 1); PG8_STAGE(PG8_SB(1, 0), b3, voffB); PG8_STAGE(PG8_SB(1, 1), b3 + hstep, voffB); PG8_STAGE(PG8_SA(1, 0), a3, voffA);
            PG8_WAIT_V(8); PG8_WAIT_L(0); PG8_BAR; PG8_MMA(1, 0, At, B0); PG8_MMA(1, 1, At, B1); PG8_BAR; PG8_SCHED;
            } else {
            PG8_LDB(B0, 0, 0); PG8_SCHED; PG8_LDA(At, 0, 0); PG8_STAGE(PG8_SA(1, 1), a1 + hstep, voffA);
            PG8_WAIT_L(8); PG8_BAR; PG8_WAIT_L(0); PG8_MMA(0, 0, At, B0); PG8_BAR; PG8_SCHED;
            PG8_LDB(B1, 0, 1); PG8_STAGE(PG8_SB(0, 0), b2, voffB);
            PG8_BAR; PG8_WAIT_L(0); PG8_MMA(0, 1, At, B1); PG8_BAR;
            PG8_LDA(At, 0, 1); PG8_STAGE(PG8_SA(0, 0), a2, voffA);
            PG8_BAR; PG8_WAIT_L(0); PG8_MMA(1, 0, At, B0); PG8_BAR; PG8_SCHED;
            PG8_STAGE(PG8_SB(0, 1), b2 + hstep, voffB);
            PG8_WAIT_V(6); PG8_BAR; PG8_MMA(1, 1, At, B1); PG8_BAR;
            PG8_LDB(B0, 1, 0); PG8_SCHED; PG8_LDA(At, 1, 0); PG8_STAGE(PG8_SA(0, 1), a2 + hstep, voffA);
            PG8_WAIT_L(8); PG8_BAR; PG8_WAIT_L(0); PG8_MMA(0, 0, At, B0); PG8_BAR; PG8_SCHED;
            PG8_LDB(B1, 1, 1); PG8_STAGE(PG8_SB(1, 0), b3, voffB);
            PG8_BAR; PG8_WAIT_L(0); PG8_MMA(0, 1, At, B1); PG8_BAR;
            PG8_LDA(At, 1, 1); PG8_STAGE(PG8_SA(1, 0), a3, voffA);
            PG8_BAR; PG8_WAIT_L(0); PG8_MMA(1, 0, At, B0); PG8_BAR; PG8_SCHED;
            PG8_STAGE(PG8_SB(1, 1), b3 + hstep, voffB);
            PG8_WAIT_V(6); PG8_BAR; PG8_MMA(1, 1, At, B1); PG8_BAR;
            }
        }
        if constexpr (ALIGN_EPI) { if (wr == 0) PG8_BAR; }
        if constexpr (!Epi::AFTER_DRAIN) { E(acc, cur, wr, wc, fr, fq); S.done(cur); }
        if (!has_next) break;
#pragma unroll
        for (int a = 0; a < 2; ++a)
#pragma unroll
            for (int b = 0; b < 2; ++b)
#pragma unroll
                for (int m = 0; m < 4; ++m)
#pragma unroll
                    for (int n = 0; n < 2; ++n) acc[a][b][m][n] = (f32x4){0.f, 0.f, 0.f, 0.f};
        cur = nxt; cA = nA; cB = nB; ++ui;
        if constexpr (ALIGN_EPI) { if (wr == 1) PG8_BAR; }
    }
    PG8_WAIT_V(0);
    if constexpr (!ALIGN_EPI) { if (wr == 0) PG8_BAR; }
    PG8_BAR;
    if constexpr (Epi::AFTER_DRAIN) { E.fused(acc, cur, wr, wc, fr, fq, lds, wid, lane); S.done(cur); }
#undef PG8_SA
#undef PG8_SB
#undef PG8_STAGE
#undef PG8_LDA
#undef PG8_LDB
#undef PG8_MMA
#undef PG8_WAIT_V
#undef PG8_WAIT_L
#undef PG8_BAR
#undef PG8_SCHED
}
}
#ifndef PG8_SP2
#define PG8_SP2 true
#endif
#define GAS __attribute__((address_space(1)))
#define LAS __attribute__((address_space(3)))
typedef unsigned short bf16;
typedef unsigned v4u __attribute__((ext_vector_type(4)));
typedef float f32x4 __attribute__((ext_vector_type(4)));
typedef short bf16x8 __attribute__((ext_vector_type(8)));
typedef GAS unsigned gu32;
typedef GAS unsigned long long gu64;
#define RLX_AGENT __ATOMIC_RELAXED, __HIP_MEMORY_SCOPE_AGENT
#define LDS_WAIT() asm volatile("s_waitcnt lgkmcnt(0)" ::: "memory")
#define VM_WAIT() asm volatile("s_waitcnt vmcnt(0)" ::: "memory")
__device__ __forceinline__ unsigned long long rt() { return __builtin_amdgcn_s_memrealtime(); }
__device__ __forceinline__ unsigned f2bf(float f) { unsigned u = __builtin_bit_cast(unsigned, f); return (u + 0x7fffu + ((u >> 16) & 1u)) >> 16; }
__device__ __forceinline__ unsigned pk2(float lo, float hi) { return f2bf(lo) | (f2bf(hi) << 16); }

#define XB_TMO      128
#define XB_XCNT(j)  (256  + 64 * (j))
#define XB_XSUB(j)  (1280 + 64 * (j))
#define XB_XGEN(j)  (2304 + 64 * (j))
#define XB_TOP      3328
#define XB_TOPGEN   3392
#define XCD_BAR_WORDS 3456
#define XB_SPIN_CAP (1u << 18)

__device__ __forceinline__ unsigned xb_ld(unsigned* p)              { return __hip_atomic_load(p, __ATOMIC_RELAXED, __HIP_MEMORY_SCOPE_AGENT); }
__device__ __forceinline__ unsigned xb_add(unsigned* p, unsigned v) { return __hip_atomic_fetch_add(p, v, __ATOMIC_RELAXED, __HIP_MEMORY_SCOPE_AGENT); }
__device__ __forceinline__ unsigned xb_xcc_id() { return (unsigned)__builtin_amdgcn_s_getreg((3 << 11) | 20) & 0xFu; }
#define XB_SPIN(cond, bar) do { unsigned _sp = 0; while (cond) { __builtin_amdgcn_s_sleep(1); \
    if ((++_sp & 255u) == 0u) { if (xb_ld(&(bar)[XB_TMO])) break; if (_sp > XB_SPIN_CAP) { atomicAdd(&(bar)[XB_TMO], 1u); break; } } } } while (0)

struct XcdBarrier {
    unsigned* bar; unsigned x;
    volatile LAS unsigned* st;
};

__device__ __forceinline__ XcdBarrier xcd_barrier_post(unsigned* bar, volatile LAS unsigned* st) {
    XcdBarrier b; b.bar = bar; b.x = xb_xcc_id(); b.st = st;
    if (threadIdx.x == 0) (void)xb_add(&bar[XB_XCNT(b.x)], 1u);
    return b;
}
__device__ __forceinline__ void xcd_barrier_complete(unsigned* bar, unsigned x, unsigned& nloc, unsigned& nx) {
    const unsigned G = gridDim.x * gridDim.y * gridDim.z;
    unsigned sum, cnt, mine, sp = 0u;
    for (;;) {
        sum = 0u; cnt = 0u; mine = 0u;
#pragma unroll
        for (unsigned j = 0; j < 16; ++j) { const unsigned c = xb_ld(&bar[XB_XCNT(j)]); sum += c; cnt += (c > 0u) ? 1u : 0u; mine = (j == x) ? c : mine; }
        if (sum == G) break;
        __builtin_amdgcn_s_sleep(1);
        if ((++sp & 255u) == 0u) { if (xb_ld(&bar[XB_TMO])) break; if (sp > XB_SPIN_CAP) { atomicAdd(&bar[XB_TMO], 1u); break; } }
    }
    nloc = mine > 0u ? mine : 1u; nx = cnt > 0u ? cnt : 1u;
}

__device__ __forceinline__ void xcd_barrier(const XcdBarrier& b) {
    asm volatile("s_waitcnt vmcnt(0)" ::: "memory");
    __syncthreads();
    if (threadIdx.x == 0) {
        unsigned* bar = b.bar;
        __builtin_amdgcn_s_waitcnt(0);
        unsigned nloc = b.st[0], nx = b.st[1];
        if (nloc == 0u) { xcd_barrier_complete(bar, b.x, nloc, nx); b.st[0] = nloc; b.st[1] = nx; }
        const unsigned old = xb_add(&bar[XB_XSUB(b.x)], 1u);
        const unsigned gen = old / nloc;
        if (old + 1u == (gen + 1u) * nloc) {
            __builtin_amdgcn_fence(__ATOMIC_RELEASE, "agent");
            asm volatile("s_waitcnt vmcnt(0)" ::: "memory");
            const unsigned og = xb_add(&bar[XB_TOP], 1u);
            const unsigned tg = og / nx;
            if (og + 1u == (tg + 1u) * nx) xb_add(&bar[XB_TOPGEN], 1u);
            else XB_SPIN(xb_ld(&bar[XB_TOPGEN]) == tg, bar);
            __builtin_amdgcn_fence(__ATOMIC_ACQUIRE, "agent");
            xb_add(&bar[XB_XGEN(b.x)], 1u);
            asm volatile("s_waitcnt vmcnt(0)" ::: "memory");
        } else {
            XB_SPIN(xb_ld(&bar[XB_XGEN(b.x)]) == gen, bar);
            __builtin_amdgcn_fence(__ATOMIC_ACQUIRE, "agent");
            asm volatile("s_waitcnt vmcnt(0)" ::: "memory");
        }
    }
    __syncthreads();
}


constexpr int NWAVES = 8;
constexpr int DM = 1024, NBP = 4, SEQ = 8192, NBS = 32, DSEQ = 64, NMETA = 16;
constexpr int DCONV = 512, NH = 4, DH = 128, DRET = 512, DFF = 4096, DIN = 3584;
constexpr int MP = NBP * SEQ, MS = NBS * DSEQ, M = MP + MS;
constexpr float NORM_EPS = 1e-6f, GN_EPS = 1e-5f;
static_assert(MP == pg8::ROWS_P && M % 256 == 0, "row geometry");
constexpr size_t O_Y = 0, O_CONVP = (size_t)M * DM, O_RETP = O_CONVP + NBP * 2 * DCONV, O_CONVS = O_RETP + (size_t)NBP * NH * DH * DH, O_RETS = O_CONVS + NBS * 2 * DCONV,
                 O_END = O_RETS + (size_t)NBS * NH * DH * DH;
constexpr size_t MiB = 1u << 20;
constexpr size_t WS_CTL = 0, CTL_ZERO_BYTES = 1 * MiB;
constexpr size_t WS_RSTD1 = 1 * MiB, WS_SSQ1 = 2 * MiB, WS_SSQ2 = 5 * MiB, WS_ROPE = 8 * MiB, WS_META = 12 * MiB;
constexpr size_t WS_WIN = 16 * MiB, WS_WOUT = 24 * MiB, WS_WUP = 26 * MiB, WS_WDN = 34 * MiB;
constexpr size_t WS_XB = 48 * MiB;
constexpr size_t WS_U = 116 * MiB, WS_BG = 150 * MiB, WS_Q = 184 * MiB, WS_K = 218 * MiB, WS_V = 252 * MiB, WS_SG = 286 * MiB;
constexpr size_t WS_MIX = 320 * MiB;
constexpr size_t WS_PART = 388 * MiB;
constexpr size_t WS_ACT = 116 * MiB;
constexpr size_t WS_TG = 388 * MiB, WS_GG = 404 * MiB, WS_SMETA = 420 * MiB;
constexpr size_t WS_END = 452 * MiB;
static_assert(WS_BG - WS_U == (size_t)M * 512 * 2 && WS_Q - WS_BG == WS_BG - WS_U && WS_K - WS_Q == WS_BG - WS_U && WS_V - WS_K == WS_BG - WS_U && WS_SG - WS_V == WS_BG - WS_U, "six bf16 regions back to back");
static_assert(WS_XB + (size_t)M * DM * 2 <= WS_U && WS_SG + (size_t)M * 512 * 2 <= WS_MIX && WS_MIX + (size_t)M * DM * 2 <= WS_TG && WS_ACT + (size_t)M * DFF * 2 <= WS_TG, "ws map");
static_assert(WS_SSQ1 + (size_t)M * 16 * 4 <= WS_SSQ2 && WS_SSQ2 + (size_t)M * 16 * 4 <= WS_ROPE && WS_ROPE + (size_t)8192 * 64 * 8 <= WS_META, "ws map small");
constexpr int CW_TMO = 0, CW_BAR = 4096;
constexpr int RING_OFF = 0, RING_BYTES = 131072, LDSCTL_OFF = RING_BYTES, MISC_OFF = LDSCTL_OFF + 320, LDS_BYTES = 147456;

struct Frame {
    LAS unsigned char* lds;
    volatile LAS unsigned* MISC;
    gu32* ctl;
    int tid, lane, wave, vcu, G;
    const float* in[14];
    float* out;
    unsigned char* ws;
};
__device__ __forceinline__ float wave_sum(float v) {
#pragma unroll
    for (int o = 1; o < 64; o <<= 1) v += __shfl_xor(v, o);
    return v;
}
__device__ __forceinline__ float bf2f(unsigned short b) { return __builtin_bit_cast(float, (unsigned)b << 16); }

__device__ __forceinline__ int win_src_col(int n0, float& sc) {
    const int pn = n0 >> 8, lc = n0 & 255; sc = 1.0f;
    if (pn < 4) return (lc < 128) ? (128 * pn + lc) : (1024 + 128 * pn + (lc - 128));
    if (pn < 6) return 512 + 256 * (pn - 4) + lc;
    if (pn < 10) { const int isk = (pn >= 8) ? 1 : 0, hp = (pn - 6) & 1, half = lc >> 7, l2 = lc & 127, head = 2 * hp + (l2 >> 6), i = l2 & 63; if (isk) sc = 0.08838834764831845f;
        return 1536 + 512 * isk + 128 * head + 64 * half + i; }
    if (pn < 12) return 2560 + 256 * (pn - 10) + lc;
    return 3072 + 256 * (pn - 12) + lc;
}
__device__ __forceinline__ void p0_transpose_item(const float* W, int K, int N, bf16* WT, int k0, int n0, int src0, const float* ks, float cs, LAS float* scr, int lane) {
#pragma unroll 8
    for (int i = 0; i < 32; ++i) { const int kk = 2 * i + (lane >> 5); const float s = ks ? ks[k0 + kk] * cs : cs; scr[kk * 33 + (lane & 31)] = W[(size_t)(k0 + kk) * N + src0 + (lane & 31)] * s; }
    LDS_WAIT(); asm volatile("" ::: "memory");
    const int c = lane & 7;
#pragma unroll
    for (int j = 0; j < 4; ++j) { const int n = (lane >> 3) + 8 * j; const LAS float* s = scr + (8 * c) * 33 + n;
        v4u o; o.x = pk2(s[0 * 33], s[1 * 33]); o.y = pk2(s[2 * 33], s[3 * 33]); o.z = pk2(s[4 * 33], s[5 * 33]); o.w = pk2(s[6 * 33], s[7 * 33]);
        *(GAS v4u*)(WT + (size_t)(n0 + n) * K + k0 + 8 * c) = o; }
    LDS_WAIT(); asm volatile("" ::: "memory");
}
__device__ __forceinline__ void x_row_to_bf16(int lane, const float* xrow, bf16* orow, float* rstd_out) {
    const GAS f32x4* xr = (const GAS f32x4*)xrow + lane;
    f32x4 v[4]; float s = 0.f;
#pragma unroll
    for (int j = 0; j < 4; ++j) { v[j] = xr[64 * j]; s += (v[j].x * v[j].x + v[j].y * v[j].y) + (v[j].z * v[j].z + v[j].w * v[j].w); }
    s = wave_sum(s);
    GAS unsigned long long* o8 = (GAS unsigned long long*)orow + lane;
#pragma unroll
    for (int j = 0; j < 4; ++j) o8[64 * j] = (unsigned long long)pk2(v[j].x, v[j].y) | ((unsigned long long)pk2(v[j].z, v[j].w) << 32);
    if (lane == 0) *rstd_out = 1.0f / sqrtf(s * (1.0f / DM) + NORM_EPS);
}
__device__ __forceinline__ void p0_prologue(Frame& F) {
    LAS float* scr = (LAS float*)(F.lds + RING_OFF + F.wave * 16384);
    const int gw = F.vcu * NWAVES + F.wave, NGW = F.G * NWAVES;
    const float* w_in = F.in[6]; const float* w_out = F.in[9]; const float* w_up = F.in[11]; const float* w_dn = F.in[12];
    bf16* WIN = (bf16*)(F.ws + WS_WIN); bf16* WOUT = (bf16*)(F.ws + WS_WOUT); bf16* WUP = (bf16*)(F.ws + WS_WUP); bf16* WDN = (bf16*)(F.ws + WS_WDN);
    constexpr int I_IN = (DM / 64) * (DIN / 32), I_OUT = (DM / 64) * (DM / 32), I_UP = (DM / 64) * (DFF / 32), I_DN = (DFF / 64) * (DM / 32);
    constexpr int NITEMS = I_IN + I_OUT + I_UP + I_DN;
    for (int it = gw; it < NITEMS; it += NGW) {
        int r = it;
        if (r < I_IN) { const int nblk = DIN / 32, kb = r / nblk, nb = r % nblk; float cs; const int src0 = win_src_col(32 * nb, cs);
            p0_transpose_item(w_in, DM, DIN, WIN, 64 * kb, 32 * nb, src0, F.in[5], cs, scr, F.lane); continue; } r -= I_IN;
        if (r < I_OUT) { const int nblk = DM / 32, kb = r / nblk, nb = r % nblk; p0_transpose_item(w_out, DM, DM, WOUT, 64 * kb, 32 * nb, 32 * nb, nullptr, 1.0f, scr, F.lane); continue; } r -= I_OUT;
        if (r < I_UP) { const int nblk = DFF / 32, kb = r / nblk, nb = r % nblk; p0_transpose_item(w_up, DM, DFF, WUP, 64 * kb, 32 * nb, 32 * nb, F.in[10], 1.0f, scr, F.lane); continue; } r -= I_UP;
        { const int nblk = DM / 32, kb = r / nblk, nb = r % nblk; p0_transpose_item(w_dn, DFF, DM, WDN, 64 * kb, 32 * nb, 32 * nb, nullptr, 1.0f, scr, F.lane); }
    }
    bf16* XB = (bf16*)(F.ws + WS_XB); float* RS = (float*)(F.ws + WS_RSTD1);
    for (int m = gw; m < M; m += NGW) { const float* xrow = (m < MP) ? F.in[0] + (size_t)m * DM : F.in[1] + (size_t)(m - MP) * DM; x_row_to_bf16(F.lane, xrow, XB + (size_t)m * DM, RS + m); }
    float* ROPE = (float*)(F.ws + WS_ROPE);
    for (int e = (F.vcu * NWAVES * 64) + F.tid; e < 8192 * 64; e += F.G * NWAVES * 64) { const int pos = e >> 6, i = e & 63;
        const float invf = (float)exp2(-(double)i * (13.287712379549449 / 64.0));
        const double rev = (double)((float)pos * invf) * 0.15915494309189535;
        const float fr = (float)(rev - __builtin_rint(rev));
        ROPE[2 * e] = __builtin_amdgcn_cosf(fr); ROPE[2 * e + 1] = __builtin_amdgcn_sinf(fr); }
}

__device__ __forceinline__ void meta_proj(Frame& F) {
    LAS float* hm = (LAS float*)(F.lds + RING_OFF);
    const float* meta = F.in[4];
    for (int rr = 0; rr < 2; ++rr) { const int row = F.wave * 2 + rr; const GAS f32x4* xr = (const GAS f32x4*)(meta + (size_t)row * DM) + F.lane;
        f32x4 v[4]; float s = 0.f;
#pragma unroll
        for (int j = 0; j < 4; ++j) { v[j] = xr[64 * j]; s += (v[j].x * v[j].x + v[j].y * v[j].y) + (v[j].z * v[j].z + v[j].w * v[j].w); }
        const float rs = 1.0f / sqrtf(wave_sum(s) * (1.0f / DM) + NORM_EPS);
#pragma unroll
        for (int j = 0; j < 4; ++j) *(LAS f32x4*)(hm + row * DM + 4 * (F.lane + 64 * j)) = v[j] * rs; }
    LDS_WAIT(); __syncthreads();
    const bf16* WIN = (const bf16*)(F.ws + WS_WIN); float* MPJ = (float*)(F.ws + WS_META);
    const int gw = F.vcu * NWAVES + F.wave, NGW = F.G * NWAVES;
    for (int n = gw; n < DIN; n += NGW) {
        const GAS v4u* wp = (const GAS v4u*)(WIN + (size_t)n * DM + 16 * F.lane); const v4u w0 = wp[0], w1 = wp[1];
        float wv[16];
        wv[0] = bf2f(w0.x & 0xffff); wv[1] = bf2f(w0.x >> 16); wv[2] = bf2f(w0.y & 0xffff); wv[3] = bf2f(w0.y >> 16); wv[4] = bf2f(w0.z & 0xffff); wv[5] = bf2f(w0.z >> 16); wv[6] = bf2f(w0.w & 0xffff); wv[7] = bf2f(w0.w >> 16);
        wv[8] = bf2f(w1.x & 0xffff); wv[9] = bf2f(w1.x >> 16); wv[10] = bf2f(w1.y & 0xffff); wv[11] = bf2f(w1.y >> 16); wv[12] = bf2f(w1.z & 0xffff); wv[13] = bf2f(w1.z >> 16); wv[14] = bf2f(w1.w & 0xffff); wv[15] = bf2f(w1.w >> 16);
        float res = 0.f;
#pragma unroll 2
        for (int row = 0; row < 16; ++row) { const LAS f32x4* h = (const LAS f32x4*)(hm + row * DM + 16 * F.lane); float a = 0.f;
#pragma unroll
            for (int q = 0; q < 4; ++q) { const f32x4 hv = h[q]; a += hv.x * wv[4 * q] + hv.y * wv[4 * q + 1] + hv.z * wv[4 * q + 2] + hv.w * wv[4 * q + 3]; }
            a = wave_sum(a); if (F.lane == row) res = a; }
        if (F.lane < 16) MPJ[(size_t)F.lane * DIN + n] = res;
    }
}
__device__ __forceinline__ int mcol_xt(int c) { return 256 * (c >> 7) + (c & 127); }
__device__ __forceinline__ int mcol_cg(int c) { return 256 * (c >> 7) + 128 + (c & 127); }
__device__ __forceinline__ int mcol_k(int head, int d) { return 256 * (8 + (head >> 1)) + 128 * (d >> 6) + 64 * (head & 1) + (d & 63); }
__device__ __forceinline__ int mcol_v(int head, int e) { return 2560 + 128 * head + e; }

__device__ __forceinline__ void conv_phase(Frame& F) {
    const bf16* U = (const bf16*)(F.ws + WS_U); const bf16* BG = (const bf16*)(F.ws + WS_BG); bf16* MIX = (bf16*)(F.ws + WS_MIX);
    const float* MPJ = (const float*)(F.ws + WS_META); const float* cw = F.in[7]; const float* sconv = F.in[2];
    const int nthr = F.G * NWAVES * 64;
    for (int item = F.vcu * NWAVES * 64 + F.tid; item < M * 64; item += nthr) {
        const int r = item >> 6, c8 = (item & 63) * 8; const bool pr = r < MP; const int t = pr ? (r & 8191) : (r & 63), T = pr ? SEQ : DSEQ;
        float u0[8], u1[8], u2[8], bg[8];
        { const v4u a = *(const GAS v4u*)(U + (size_t)r * 512 + c8); u0[0] = bf2f(a.x & 0xffff); u0[1] = bf2f(a.x >> 16); u0[2] = bf2f(a.y & 0xffff); u0[3] = bf2f(a.y >> 16); u0[4] = bf2f(a.z & 0xffff); u0[5] = bf2f(a.z >> 16); u0[6] = bf2f(a.w & 0xffff); u0[7] = bf2f(a.w >> 16); }
        { const v4u a = *(const GAS v4u*)(BG + (size_t)r * 512 + c8); bg[0] = bf2f(a.x & 0xffff); bg[1] = bf2f(a.x >> 16); bg[2] = bf2f(a.y & 0xffff); bg[3] = bf2f(a.y >> 16); bg[4] = bf2f(a.z & 0xffff); bg[5] = bf2f(a.z >> 16); bg[6] = bf2f(a.w & 0xffff); bg[7] = bf2f(a.w >> 16); }
        if (t >= 1) { const v4u a = *(const GAS v4u*)(U + (size_t)(r - 1) * 512 + c8); u1[0] = bf2f(a.x & 0xffff); u1[1] = bf2f(a.x >> 16); u1[2] = bf2f(a.y & 0xffff); u1[3] = bf2f(a.y >> 16); u1[4] = bf2f(a.z & 0xffff); u1[5] = bf2f(a.z >> 16); u1[6] = bf2f(a.w & 0xffff); u1[7] = bf2f(a.w >> 16); }
        if (t >= 2) { const v4u a = *(const GAS v4u*)(U + (size_t)(r - 2) * 512 + c8); u2[0] = bf2f(a.x & 0xffff); u2[1] = bf2f(a.x >> 16); u2[2] = bf2f(a.y & 0xffff); u2[3] = bf2f(a.y >> 16); u2[4] = bf2f(a.z & 0xffff); u2[5] = bf2f(a.z >> 16); u2[6] = bf2f(a.w & 0xffff); u2[7] = bf2f(a.w >> 16); }
        if (t < 2) {
#pragma unroll
            for (int j = 0; j < 8; ++j) { const int c = c8 + j; float h0, h1;
                if (pr) { h0 = MPJ[(size_t)14 * DIN + mcol_xt(c)] * MPJ[(size_t)14 * DIN + mcol_cg(c)]; h1 = MPJ[(size_t)15 * DIN + mcol_xt(c)] * MPJ[(size_t)15 * DIN + mcol_cg(c)]; }
                else { const int s = (r - MP) >> 6; h0 = sconv[((size_t)s * 2 + 0) * DCONV + c]; h1 = sconv[((size_t)s * 2 + 1) * DCONV + c]; }
                if (t == 0) { u1[j] = h1; u2[j] = h0; } else { u2[j] = h1; } }
        }
        float o[8];
#pragma unroll
        for (int j = 0; j < 8; ++j) { const int c = c8 + j; o[j] = bg[j] * (cw[c] * u2[j] + cw[DCONV + c] * u1[j] + cw[2 * DCONV + c] * u0[j]); }
        v4u w; w.x = pk2(o[0], o[1]); w.y = pk2(o[2], o[3]); w.z = pk2(o[4], o[5]); w.w = pk2(o[6], o[7]);
        *(GAS v4u*)(MIX + (size_t)r * DM + c8) = w;
        if (t >= T - 2) { float* dst = pr ? F.out + O_CONVP + ((size_t)(r >> 13) * 2 + (t - (T - 2))) * DCONV + c8 : F.out + O_CONVS + ((size_t)((r - MP) >> 6) * 2 + (t - (T - 2))) * DCONV + c8;
            *(f32x4*)dst = (f32x4){u0[0], u0[1], u0[2], u0[3]}; *(f32x4*)(dst + 4) = (f32x4){u0[4], u0[5], u0[6], u0[7]}; }
    }
}

namespace ret {
constexpr int QS = 0, KS = 17408, KT = 34816, VT = 53248, AS = 71680, ST = 80896;
constexpr int QSTR = 272, TSTR = 144;
__device__ __forceinline__ unsigned short el16(const v4u& w, int k) { const unsigned x = (k >> 1) == 0 ? w.x : (k >> 1) == 1 ? w.y : (k >> 1) == 2 ? w.z : w.w; return (k & 1) ? (unsigned short)(x >> 16) : (unsigned short)(x & 0xffffu); }
typedef unsigned long long u64;
typedef float f32x2 __attribute__((ext_vector_type(2)));

template <bool FULL>
__device__ __forceinline__ void ret_task(Frame& F, int row0, int nchunks, int head, const float* s_init_native, const float* s_init_de, float* s_out_native, float* s_out_de) {
    const int lane = F.lane, w = F.wave, q = lane >> 4, c15 = lane & 15;
    LAS unsigned char* L = F.lds;
    const bf16* Qg = (const bf16*)(F.ws + WS_Q); const bf16* Kg = (const bf16*)(F.ws + WS_K); const bf16* Vg = (const bf16*)(F.ws + WS_V); const bf16* SGg = (const bf16*)(F.ws + WS_SG);
    bf16* MIX = (bf16*)(F.ws + WS_MIX);
    const float lg2 = log2f(1.0f - exp2f(-5.0f - (float)head));
    const float dec = exp2f(lg2 * (float)(63 - lane)), g64 = exp2f(lg2 * 64.0f);
    f32x4 S[8];
    if (s_init_native) {
#pragma unroll
        for (int db = 0; db < 8; ++db) S[db] = *(const f32x4*)(s_init_native + ((size_t)(w * 8 + db) * 64 + lane) * 4);
    } else if (s_init_de) {
#pragma unroll
        for (int db = 0; db < 8; ++db)
#pragma unroll
            for (int r = 0; r < 4; ++r) S[db][r] = s_init_de[(size_t)(16 * db + 4 * q + r) * 128 + 16 * w + c15];
    } else {
#pragma unroll
        for (int db = 0; db < 8; ++db) S[db] = (f32x4){0.f, 0.f, 0.f, 0.f};
    }
    float cd[4]; f32x4 gw4 = (f32x4){0.f, 0.f, 0.f, 0.f};
    if (FULL) {
#pragma unroll
        for (int ib = 0; ib < 4; ++ib) cd[ib] = exp2f(lg2 * (float)(16 * ib + c15 + 1));
        gw4 = *(const f32x4*)(F.in[8] + 128 * head + 16 * w + 4 * q);
    }
    v4u pq[2], pk[2], pv[2];
#define RET_ISSUE(ch) do { _Pragma("unroll") for (int pi = 0; pi < 2; ++pi) { const size_t off = (size_t)(row0 + (ch) * 64 + lane) * 512 + 128 * head + 8 * (w + 8 * pi); \
        if (FULL) pq[pi] = *(const GAS v4u*)(Qg + off); pk[pi] = *(const GAS v4u*)(Kg + off); pv[pi] = *(const GAS v4u*)(Vg + off); } } while (0)
    RET_ISSUE(0);
    for (int ch = 0; ch < nchunks; ++ch) {
#pragma unroll
        for (int pi = 0; pi < 2; ++pi) { const int c = w + 8 * pi;
            if (FULL) { *(LAS v4u*)(L + QS + lane * QSTR + 16 * c) = pq[pi]; *(LAS v4u*)(L + KS + lane * QSTR + 16 * c) = pk[pi]; }
#pragma unroll
            for (int k = 0; k < 8; ++k) { *(LAS unsigned short*)(L + KT + (8 * c + k) * TSTR + 2 * lane) = (unsigned short)f2bf(bf2f(el16(pk[pi], k)) * dec);
                *(LAS unsigned short*)(L + VT + (8 * c + k) * TSTR + 2 * lane) = el16(pv[pi], k); } }
        if (ch + 1 < nchunks) RET_ISSUE(ch + 1);
        LDS_WAIT(); __builtin_amdgcn_s_barrier(); asm volatile("" ::: "memory");
        if (FULL) {
            const int mi = w >> 1;
#pragma unroll
            for (int t = 0; t < 2; ++t) { const int nj = 2 * (w & 1) + t; f32x4 a4 = (f32x4){0.f, 0.f, 0.f, 0.f};
#pragma unroll
                for (int s = 0; s < 4; ++s) { const bf16x8 a = *(const LAS bf16x8*)(L + KS + (16 * nj + c15) * QSTR + (32 * s + 8 * q) * 2), b = *(const LAS bf16x8*)(L + QS + (16 * mi + c15) * QSTR + (32 * s + 8 * q) * 2);
                    a4 = __builtin_amdgcn_mfma_f32_16x16x32_bf16(a, b, a4, 0, 0, 0); }
                const int i = 16 * mi + c15; float v[4];
#pragma unroll
                for (int r = 0; r < 4; ++r) { const int j = 16 * nj + 4 * q + r; v[r] = (i >= j) ? a4[r] * exp2f(lg2 * (float)(i - j)) : 0.f; }
                *(LAS u64*)(L + AS + i * TSTR + (16 * nj + 4 * q) * 2) = (u64)pk2(v[0], v[1]) | ((u64)pk2(v[2], v[3]) << 32); }
            LDS_WAIT(); __builtin_amdgcn_s_barrier(); asm volatile("" ::: "memory");
        }
        bf16x8 vt[2];
#pragma unroll
        for (int s = 0; s < 2; ++s) vt[s] = *(const LAS bf16x8*)(L + VT + (16 * w + c15) * TSTR + (32 * s + 8 * q) * 2);
        f32x4 acc[4];
        if (FULL) {
#pragma unroll
            for (int ib = 0; ib < 4; ++ib) acc[ib] = (f32x4){0.f, 0.f, 0.f, 0.f};
#pragma unroll
            for (int s = 0; s < 4; ++s) { v4u aw; aw.x = pk2(S[2 * s][0], S[2 * s][1]); aw.y = pk2(S[2 * s][2], S[2 * s][3]); aw.z = pk2(S[2 * s + 1][0], S[2 * s + 1][1]); aw.w = pk2(S[2 * s + 1][2], S[2 * s + 1][3]);
                const bf16x8 a = __builtin_bit_cast(bf16x8, aw);
#pragma unroll
                for (int ib = 0; ib < 4; ++ib) { const u64 lo = *(const LAS u64*)(L + QS + (16 * ib + c15) * QSTR + (32 * s + 4 * q) * 2), hi = *(const LAS u64*)(L + QS + (16 * ib + c15) * QSTR + (32 * s + 16 + 4 * q) * 2);
                    v4u bw; bw.x = (unsigned)lo; bw.y = (unsigned)(lo >> 32); bw.z = (unsigned)hi; bw.w = (unsigned)(hi >> 32);
                    acc[ib] = __builtin_amdgcn_mfma_f32_16x16x32_bf16(a, __builtin_bit_cast(bf16x8, bw), acc[ib], 0, 0, 0); } }
#pragma unroll
            for (int ib = 0; ib < 4; ++ib) acc[ib] = acc[ib] * cd[ib];
#pragma unroll
            for (int ib = 0; ib < 4; ++ib)
#pragma unroll
                for (int s = 0; s < 2; ++s) { if (s == 1 && ib < 2) continue;
                    const bf16x8 b = *(const LAS bf16x8*)(L + AS + (16 * ib + c15) * TSTR + (32 * s + 8 * q) * 2);
                    acc[ib] = __builtin_amdgcn_mfma_f32_16x16x32_bf16(vt[s], b, acc[ib], 0, 0, 0); }
        }
#pragma unroll
        for (int db = 0; db < 8; ++db) { S[db] = S[db] * g64;
#pragma unroll
            for (int s = 0; s < 2; ++s) { const bf16x8 a = *(const LAS bf16x8*)(L + KT + (16 * db + c15) * TSTR + (32 * s + 8 * q) * 2);
                S[db] = __builtin_amdgcn_mfma_f32_16x16x32_bf16(a, vt[s], S[db], 0, 0, 0); } }
        if (FULL) {
#pragma unroll
            for (int ib = 0; ib < 4; ++ib) { float s1 = (acc[ib][0] + acc[ib][1]) + (acc[ib][2] + acc[ib][3]); s1 += __shfl_xor(s1, 16); s1 += __shfl_xor(s1, 32);
                const float mw = s1 * (1.0f / 16.0f); const f32x4 dd = acc[ib] - mw; float m2 = (dd[0] * dd[0] + dd[1] * dd[1]) + (dd[2] * dd[2] + dd[3] * dd[3]); m2 += __shfl_xor(m2, 16); m2 += __shfl_xor(m2, 32);
                if (q == 0) *(LAS f32x2*)(L + ST + ((16 * ib + c15) * 8 + w) * 8) = (f32x2){mw, m2}; }
            LDS_WAIT(); __builtin_amdgcn_s_barrier(); asm volatile("" ::: "memory");
#pragma unroll
            for (int ib = 0; ib < 4; ++ib) { const int i = 16 * ib + c15; const LAS f32x4* sp = (const LAS f32x4*)(L + ST + i * 64);
                const f32x4 p0 = sp[0], p1 = sp[1], p2 = sp[2], p3 = sp[3];
                const float mean = ((p0[0] + p0[2]) + (p1[0] + p1[2]) + (p2[0] + p2[2]) + (p3[0] + p3[2])) * 0.125f;
                const float d0 = p0[0] - mean, d1 = p0[2] - mean, d2 = p1[0] - mean, d3 = p1[2] - mean, d4 = p2[0] - mean, d5 = p2[2] - mean, d6 = p3[0] - mean, d7 = p3[2] - mean;
                const float M2 = ((p0[1] + p0[3]) + (p1[1] + p1[3]) + (p2[1] + p2[3]) + (p3[1] + p3[3])) + 16.0f * ((d0 * d0 + d1 * d1) + (d2 * d2 + d3 * d3) + (d4 * d4 + d5 * d5) + (d6 * d6 + d7 * d7));
                const float rsd = 1.0f / sqrtf(M2 * (1.0f / 128.0f) + GN_EPS);
                const size_t row = (size_t)(row0 + ch * 64 + i); const int cc = 128 * head + 16 * w + 4 * q;
                const u64 sgw = *(const GAS u64*)(SGg + row * 512 + cc);
                const float o0 = (acc[ib][0] - mean) * rsd * gw4[0] * bf2f((unsigned short)(sgw & 0xffff)), o1 = (acc[ib][1] - mean) * rsd * gw4[1] * bf2f((unsigned short)((sgw >> 16) & 0xffff));
                const float o2 = (acc[ib][2] - mean) * rsd * gw4[2] * bf2f((unsigned short)((sgw >> 32) & 0xffff)), o3 = (acc[ib][3] - mean) * rsd * gw4[3] * bf2f((unsigned short)(sgw >> 48));
                *(GAS u64*)(MIX + row * DM + 512 + cc) = (u64)pk2(o0, o1) | ((u64)pk2(o2, o3) << 32); }
        } else {
            LDS_WAIT(); __builtin_amdgcn_s_barrier(); asm volatile("" ::: "memory");
        }
    }
#undef RET_ISSUE
    if (s_out_native) {
#pragma unroll
        for (int db = 0; db < 8; ++db) *(f32x4*)(s_out_native + ((size_t)(w * 8 + db) * 64 + lane) * 4) = S[db];
    }
    if (s_out_de) {
#pragma unroll
        for (int db = 0; db < 8; ++db)
#pragma unroll
            for (int r = 0; r < 4; ++r) s_out_de[(size_t)(16 * db + 4 * q + r) * 128 + 16 * w + c15] = S[db][r];
    }
    __syncthreads();
}
__device__ __forceinline__ void smeta_task(Frame& F, int head, float* out_native) {
    LAS float* km = (LAS float*)(F.lds); LAS float* vm = km + 2048;
    const float* MPJ = (const float*)(F.ws + WS_META); const float* ROPE = (const float*)(F.ws + WS_ROPE);
    const float lg2 = log2f(1.0f - exp2f(-5.0f - (float)head));
    __syncthreads();
    for (int idx = F.tid; idx < 2048; idx += 512) { const int j = idx >> 7, d = idx & 127, i = d & 63, ap = 16 - j;
        const float x1 = MPJ[(size_t)j * DIN + mcol_k(head, i)], x2 = MPJ[(size_t)j * DIN + mcol_k(head, 64 + i)];
        const float c = ROPE[2 * (ap * 64 + i)], s = -ROPE[2 * (ap * 64 + i) + 1];
        km[idx] = ((d < 64) ? (x1 * c - x2 * s) : (x1 * s + x2 * c)) * exp2f(lg2 * (float)(15 - j));
        vm[idx] = MPJ[(size_t)j * DIN + mcol_v(head, d)]; }
    LDS_WAIT(); __syncthreads();
    const int lane = F.lane, w = F.wave, q = lane >> 4, c15 = lane & 15;
    for (int db = 0; db < 8; ++db) { f32x4 o;
#pragma unroll
        for (int r = 0; r < 4; ++r) { const int d = 16 * db + 4 * q + r, e = 16 * w + c15; float a = 0.f;
            for (int j = 0; j < 16; ++j) a += km[j * 128 + d] * vm[j * 128 + e];
            o[r] = a; }
        *(f32x4*)(out_native + ((size_t)(w * 8 + db) * 64 + lane) * 4) = o; }
    __syncthreads();
}
}
#if RET_ORACLE
__device__ __forceinline__ void ret_oracle_task(Frame& F, int stream, int head, bf16* MIXO, float* retp, float* rets) {
    LAS float* S = (LAS float*)(F.lds);
    LAS bf16* qs = (LAS bf16*)(F.lds + 65536); LAS bf16* ks = (LAS bf16*)(F.lds + 81920); LAS bf16* vs = (LAS bf16*)(F.lds + 98304);
    LAS float* sc = (LAS float*)(F.lds + 114688);
    const bf16* Q = (const bf16*)(F.ws + WS_Q); const bf16* Kb = (const bf16*)(F.ws + WS_K); const bf16* V = (const bf16*)(F.ws + WS_V); const bf16* SG = (const bf16*)(F.ws + WS_SG);
    const float* MPJ = (const float*)(F.ws + WS_META); const float* ROPE = (const float*)(F.ws + WS_ROPE); const float* gnw = F.in[8];
    const float lg = logf(1.0f - exp2f(-5.0f - (float)head));
    const bool pr = stream < NBP; const int tid = F.tid;
    __syncthreads();
    if (pr) {
        LAS float* km = sc; LAS float* vm = sc + 2048;
        for (int idx = tid; idx < 2048; idx += 512) { const int j = idx >> 7, d = idx & 127, i = d & 63, ap = 16 - j;
            const float x1 = MPJ[(size_t)j * DIN + mcol_k(head, i)], x2 = MPJ[(size_t)j * DIN + mcol_k(head, 64 + i)];
            const float c = ROPE[2 * (ap * 64 + i)], s = -ROPE[2 * (ap * 64 + i) + 1];
            km[idx] = (d < 64) ? (x1 * c - x2 * s) : (x1 * s + x2 * c);
            vm[idx] = MPJ[(size_t)j * DIN + mcol_v(head, d)]; }
        LDS_WAIT(); __syncthreads();
        for (int idx = tid; idx < 16384; idx += 512) { const int d = idx >> 7, e = idx & 127; float a = 0.f;
            for (int j = 0; j < 16; ++j) a += km[j * 128 + d] * __expf(lg * (float)(15 - j)) * vm[j * 128 + e];
            S[idx] = a; }
    } else {
        const float* sr = F.in[3] + ((size_t)(stream - NBP) * NH + head) * DH * DH;
        for (int idx = tid; idx < 16384; idx += 512) S[idx] = sr[idx];
    }
    LDS_WAIT(); __syncthreads();
    const int nchunk = pr ? SEQ / 64 : 1;
    for (int ch = 0; ch < nchunk; ++ch) {
        const int row0 = pr ? stream * SEQ + ch * 64 : MP + (stream - NBP) * 64;
        for (int x = tid; x < 1024; x += 512) { const int i = x >> 4, c8 = (x & 15) * 8; const size_t g = (size_t)(row0 + i) * 512 + head * 128 + c8;
            *(LAS v4u*)(qs + i * 128 + c8) = *(const GAS v4u*)(Q + g); *(LAS v4u*)(ks + i * 128 + c8) = *(const GAS v4u*)(Kb + g); *(LAS v4u*)(vs + i * 128 + c8) = *(const GAS v4u*)(V + g); }
        LDS_WAIT(); __syncthreads();
        { const int i = tid >> 3, jg = tid & 7;
            for (int jj = 0; jj < 8; ++jj) { const int j = 8 * jg + jj; float a = 0.f;
                if (j <= i) { for (int d = 0; d < 128; ++d) a += bf2f(qs[i * 128 + d]) * bf2f(ks[j * 128 + d]); a *= __expf(lg * (float)(i - j)); }
                sc[i * 64 + j] = a; } }
        LDS_WAIT(); __syncthreads();
        { const int i = tid >> 3, eg = tid & 7, e0 = 16 * eg; float acc[16];
#pragma unroll
            for (int e = 0; e < 16; ++e) acc[e] = 0.f;
            for (int j = 0; j <= i; ++j) { const float s = sc[i * 64 + j];
#pragma unroll
                for (int e = 0; e < 16; ++e) acc[e] += s * bf2f(vs[j * 128 + e0 + e]); }
            const float cd = __expf(lg * (float)(i + 1));
            for (int d = 0; d < 128; ++d) { const float qd = bf2f(qs[i * 128 + d]) * cd;
#pragma unroll
                for (int e = 0; e < 16; ++e) acc[e] += qd * S[d * 128 + e0 + e]; }
            float sum = 0.f;
#pragma unroll
            for (int e = 0; e < 16; ++e) sum += acc[e];
            sum += __shfl_xor(sum, 1); sum += __shfl_xor(sum, 2); sum += __shfl_xor(sum, 4);
            const float mu = sum * (1.0f / 128.0f); float var = 0.f;
#pragma unroll
            for (int e = 0; e < 16; ++e) { const float dd = acc[e] - mu; var += dd * dd; }
            var += __shfl_xor(var, 1); var += __shfl_xor(var, 2); var += __shfl_xor(var, 4);
            const float rsd = 1.0f / sqrtf(var * (1.0f / 128.0f) + GN_EPS);
            const size_t r = (size_t)(row0 + i);
#pragma unroll
            for (int e = 0; e < 16; e += 2) { const int cc = head * 128 + e0 + e;
                const float o0 = (acc[e] - mu) * rsd * gnw[cc] * bf2f(SG[r * 512 + cc]), o1 = (acc[e + 1] - mu) * rsd * gnw[cc + 1] * bf2f(SG[r * 512 + cc + 1]);
                *(GAS unsigned*)(MIXO + r * DM + 512 + cc) = pk2(o0, o1); } }
        __syncthreads();
        { const int d = tid >> 2, e0 = 32 * (tid & 3); float acc[32]; const float g64 = __expf(lg * 64.0f);
#pragma unroll
            for (int e = 0; e < 32; ++e) acc[e] = g64 * S[d * 128 + e0 + e];
            for (int j = 0; j < 64; ++j) { const float kd = bf2f(ks[j * 128 + d]) * __expf(lg * (float)(63 - j));
#pragma unroll
                for (int e = 0; e < 32; ++e) acc[e] += kd * bf2f(vs[j * 128 + e0 + e]); }
#pragma unroll
            for (int e = 0; e < 32; ++e) S[d * 128 + e0 + e] = acc[e]; }
        LDS_WAIT(); __syncthreads();
    }
    float* dst = pr ? retp + ((size_t)stream * NH + head) * DH * DH : rets + ((size_t)(stream - NBP) * NH + head) * DH * DH;
    for (int idx = tid; idx < 16384; idx += 512) dst[idx] = S[idx];
    __syncthreads();
}

#endif
__device__ __forceinline__ void scan_phase(Frame& F) {
    const f32x4* TG = (const f32x4*)(F.ws + WS_TG); f32x4* GG = (f32x4*)(F.ws + WS_GG); const f32x4* SM = (const f32x4*)(F.ws + WS_SMETA);
    const int nthr = F.G * NWAVES * 64;
    for (int x = F.vcu * NWAVES * 64 + F.tid; x < 16 * 4096; x += nthr) { const int bh = x >> 12, f4 = x & 4095, h = bh & 3;
        const float g512 = exp2f(log2f(1.0f - exp2f(-5.0f - (float)h)) * 512.0f);
        f32x4 t[16];
#pragma unroll
        for (int g = 0; g < 16; ++g) t[g] = TG[(size_t)(bh * 16 + g) * 4096 + f4];
        f32x4 G = SM[(size_t)h * 4096 + f4];
#pragma unroll
        for (int g = 0; g < 16; ++g) { GG[(size_t)(bh * 16 + g) * 4096 + f4] = G; G = G * g512 + t[g]; } }
}
__device__ __forceinline__ void final_norm(Frame& F) {
    const float* wf = F.in[13]; const float* part = (const float*)(F.ws + WS_PART); const bool split = (F.G == 256);
    const int gw = F.vcu * NWAVES + F.wave, NGW = F.G * NWAVES;
    f32x4 wv[4];
#pragma unroll
    for (int j = 0; j < 4; ++j) wv[j] = *(const f32x4*)(wf + 4 * (F.lane + 64 * j));
    for (int m = gw; m < M; m += NGW) {
        GAS f32x4* p = (GAS f32x4*)(F.out + (size_t)m * DM) + F.lane; f32x4 v[4];
        if (split && m >= MP) {
            const GAS unsigned long long* hb = (const GAS unsigned long long*)((const bf16*)(F.ws + WS_XB) + (size_t)m * DM) + F.lane;
#pragma unroll
            for (int j = 0; j < 4; ++j) { const unsigned long long w = hb[64 * j]; const unsigned lo = (unsigned)w, hi = (unsigned)(w >> 32);
                v[j] = (f32x4){__builtin_bit_cast(float, lo << 16), __builtin_bit_cast(float, lo & 0xffff0000u), __builtin_bit_cast(float, hi << 16), __builtin_bit_cast(float, hi & 0xffff0000u)}; }
#pragma unroll
            for (int kp = 0; kp < 8; ++kp) { const GAS f32x4* q = (const GAS f32x4*)(part + ((size_t)kp * MS + (m - MP)) * DM) + F.lane;
#pragma unroll
                for (int j = 0; j < 4; ++j) v[j] = v[j] + q[64 * j]; }
        } else {
#pragma unroll
            for (int j = 0; j < 4; ++j) v[j] = p[64 * j];
        }
        float s = 0.f;
#pragma unroll
        for (int j = 0; j < 4; ++j) s += (v[j].x * v[j].x + v[j].y * v[j].y) + (v[j].z * v[j].z + v[j].w * v[j].w);
        const float rs = 1.0f / sqrtf(wave_sum(s) * (1.0f / DM) + NORM_EPS);
#pragma unroll
        for (int j = 0; j < 4; ++j) p[64 * j] = v[j] * rs * wv[j];
    }
}

constexpr int N_PHASES = 9;
struct Args { const float* in[14]; float* out; unsigned char* ws; int ph_lo, ph_hi; };
static_assert(sizeof(Args) == 14 * 8 + 8 + 8 + 8, "Args has no padding");
__global__ void __launch_bounds__(NWAVES * 64, 2) mk_fwd(Args args) {
    extern __shared__ __attribute__((aligned(16))) unsigned char lds[];
    Frame F;
    F.lds = (LAS unsigned char*)lds;
    F.MISC = (volatile LAS unsigned*)(F.lds + MISC_OFF);
    F.tid = threadIdx.x; F.lane = F.tid & 63; F.wave = __builtin_amdgcn_readfirstlane(F.tid >> 6);
    F.G = gridDim.x; { const int bx = blockIdx.x; F.vcu = (F.G % 8 == 0) ? (bx % 8) * (F.G / 8) + bx / 8 : bx; }
    F.ws = args.ws; F.out = args.out; F.ctl = (gu32*)(args.ws + WS_CTL);
#pragma unroll
    for (int i = 0; i < 14; ++i) F.in[i] = args.in[i];
    for (int u = F.tid; u < (LDS_BYTES - LDSCTL_OFF) / 4; u += NWAVES * 64) ((LAS unsigned*)(F.lds + LDSCTL_OFF))[u] = 0u;
    __syncthreads();
    const int lo = args.ph_lo, hi = args.ph_hi;
    const bool one_launch = (lo == 0 && hi == N_PHASES);
    XcdBarrier bar; bar.bar = (unsigned*)(F.ctl + CW_BAR); bar.x = 0; bar.st = nullptr;
    if (one_launch) bar = xcd_barrier_post((unsigned*)(F.ctl + CW_BAR), F.MISC + 8);
#define IN(k) (lo <= (k) && (k) < hi)
#ifndef PROBE_DUP
#define PROBE_DUP 0
#endif
#define REP(k) _Pragma("nounroll") for (int rep_ = 0; rep_ < (((PROBE_DUP >> (k)) & 1) ? 2 : 1); ++rep_)
#ifndef PROBE_SPIN
#define PROBE_SPIN -1
#endif
#define STAMP(k) do { if (PROBE_SPIN >= 0 && blockIdx.x == 0 && F.tid == 0) { const unsigned long long t_ = rt(); F.MISC[32 + 2 * (k)] = (unsigned)t_; F.MISC[33 + 2 * (k)] = (unsigned)(t_ >> 32); } } while (0)
#define SEAM(k) do { if (IN(k) && IN((k) + 1)) xcd_barrier(bar); STAMP((k) + 1); } while (0)

    STAMP(0);
    REP(0) if (IN(0)) { p0_prologue(F); } SEAM(0);
    if (IN(1)) {
        pg8::Gemm g{(const pg8::bf16_t*)(F.ws + WS_XB), (const pg8::bf16_t*)(F.ws + WS_WIN), M, DIN, DM}; pg8::StaticOrder S; S.init(M, DIN, F.G, (int)blockIdx.x, DM / 64);
        pg8::EpiIn E{(pg8::bf16_t*)(F.ws + WS_U), (const float*)(F.ws + WS_RSTD1), (const float*)(F.ws + WS_ROPE)};
        pg8::gemm_phase<pg8::EpiIn, pg8::StaticOrder, true, true>(F.lds + RING_OFF, g, S, E);
        meta_proj(F);
    } SEAM(1);
    {
    if (IN(2)) {
        REP(8) conv_phase(F);
        REP(9) for (int t = blockIdx.x; t < 260; t += F.G) {
            if (t < 256) { const int bh = t >> 4, g = t & 15; ret::ret_task<false>(F, (bh >> 2) * SEQ + g * 512, 8, bh & 3, nullptr, nullptr, (float*)(F.ws + WS_TG) + (size_t)t * 16384, nullptr); }
            else ret::smeta_task(F, t - 256, (float*)(F.ws + WS_SMETA) + (size_t)(t - 256) * 16384);
        }
    } SEAM(2);
    REP(3) if (IN(3)) { scan_phase(F); } SEAM(3);
    if (IN(4)) {
        REP(4) for (int t = blockIdx.x; t < 384; t += F.G) {
            int row0, nch, head; const float* sn = nullptr; const float* sd = nullptr; float* od = nullptr;
            if (t < 256) { const int bh = t >> 4, g = t & 15; row0 = (bh >> 2) * SEQ + g * 512; nch = 8; head = bh & 3; sn = (const float*)(F.ws + WS_GG) + (size_t)t * 16384; if (g == 15) od = F.out + O_RETP + (size_t)bh * 16384; }
            else { const int sh = t - 256; row0 = MP + (sh >> 2) * 64; nch = 1; head = sh & 3; sd = F.in[3] + (size_t)sh * 16384; od = F.out + O_RETS + (size_t)sh * 16384; }
            ret::ret_task<true>(F, row0, nch, head, sn, sd, nullptr, od);
        }
#if RET_ORACLE

#endif
    } SEAM(4);
    }
    if (IN(5)) {
        pg8::Gemm g{(const pg8::bf16_t*)(F.ws + WS_MIX), (const pg8::bf16_t*)(F.ws + WS_WOUT), M, DM, DM}; pg8::StaticOrder S; S.init(M, DM, F.G, (int)blockIdx.x, DM / 64);
        pg8::EpiOut E{F.in[0], F.in[1], (pg8::bf16_t*)(F.ws + WS_XB), (float*)(F.ws + WS_SSQ1)};
        pg8::gemm_phase<pg8::EpiOut, pg8::StaticOrder, true, true>(F.lds + RING_OFF, g, S, E);
    } SEAM(5);
    if (IN(6)) {
        pg8::Gemm g{(const pg8::bf16_t*)(F.ws + WS_XB), (const pg8::bf16_t*)(F.ws + WS_WUP), M, DFF, DM}; pg8::StaticOrder S; S.init(M, DFF, F.G, (int)blockIdx.x, DM / 64);
        pg8::EpiUp E{(pg8::bf16_t*)(F.ws + WS_ACT), (const float*)(F.ws + WS_SSQ1), NORM_EPS};
        pg8::gemm_phase<pg8::EpiUp, pg8::StaticOrder, true, true>(F.lds + RING_OFF, g, S, E);
    } SEAM(6);
    if (IN(7)) {
        pg8::Gemm g{(const pg8::bf16_t*)(F.ws + WS_ACT), (const pg8::bf16_t*)(F.ws + WS_WDN), M, DM, DFF}; pg8::SplitOrder S; S.init(M, MP, DM, F.G, (int)blockIdx.x, DFF / 64);
        pg8::EpiDown E{F.out + O_Y, (float*)(F.ws + WS_PART), (const pg8::bf16_t*)(F.ws + WS_XB)};
        pg8::gemm_phase<pg8::EpiDown, pg8::SplitOrder, true, true>(F.lds + RING_OFF, g, S, E);
    } SEAM(7);
    if (IN(8)) { final_norm(F); }
    if (PROBE_SPIN >= 0 && blockIdx.x == 0 && F.tid == 0) { asm volatile("s_waitcnt vmcnt(0)" ::: "memory"); const unsigned long long te = rt(); if (PROBE_SPIN == 8) { F.MISC[32 + 18] = (unsigned)te; F.MISC[33 + 18] = (unsigned)(te >> 32); }
        const unsigned long long a_ = ((unsigned long long)F.MISC[33 + 2 * PROBE_SPIN] << 32) | F.MISC[32 + 2 * PROBE_SPIN], b_ = ((unsigned long long)F.MISC[35 + 2 * PROBE_SPIN] << 32) | F.MISC[34 + 2 * PROBE_SPIN];
        const unsigned long long tgt = 4ull * (b_ - a_); while (rt() - te < tgt) __builtin_amdgcn_s_sleep(8); }
#undef IN
#undef SEAM
}

#ifndef MK_ONE_LAUNCH
#define MK_ONE_LAUNCH 1
#endif
extern "C" void kernel_launch(void* const* d_in, const int* in_sizes, int n_in, void* d_out, int out_size, void* d_ws, size_t ws_size, hipStream_t stream) {
    static int grid = 0;
    if (grid == 0) {
        if (n_in != 14 || in_sizes[0] != MP * DM || in_sizes[1] != MS * DM || (size_t)out_size != O_END || ws_size < WS_END) {
            fprintf(stderr, "kernel_launch: unexpected shapes: n_in %d in0 %d in1 %d out %d ws %zu (need %zu); nothing launched\n", n_in, n_in > 0 ? in_sizes[0] : -1, n_in > 1 ? in_sizes[1] : -1, out_size, ws_size, (size_t)WS_END); grid = -1; return; }
        int dev = 0, cus = 0;
        if (hipGetDevice(&dev) != hipSuccess || hipDeviceGetAttribute(&cus, hipDeviceAttributeMultiprocessorCount, dev) != hipSuccess) { fprintf(stderr, "kernel_launch: device query failed\n"); grid = -1; return; }
        if (hipFuncSetAttribute((const void*)mk_fwd, hipFuncAttributeMaxDynamicSharedMemorySize, LDS_BYTES) != hipSuccess) { fprintf(stderr, "kernel_launch: hipFuncSetAttribute failed\n"); grid = -1; return; }
        int per_cu = 0;
        if (hipOccupancyMaxActiveBlocksPerMultiprocessor(&per_cu, (const void*)mk_fwd, NWAVES * 64, LDS_BYTES) != hipSuccess || per_cu < 1) fprintf(stderr, "kernel_launch: occupancy query says %d per CU\n", per_cu);
        (void)hipGetLastError();
        grid = cus;
    }
    if (grid < 0) return;
    if (hipMemsetAsync((char*)d_ws + WS_CTL, 0, CTL_ZERO_BYTES, stream) != hipSuccess) { fprintf(stderr, "kernel_launch: memset failed\n"); return; }
    Args a{};
    for (int i = 0; i < 14; ++i) a.in[i] = (const float*)d_in[i];
    a.out = (float*)d_out; a.ws = (unsigned char*)d_ws;
#if MK_ONE_LAUNCH
    a.ph_lo = 0; a.ph_hi = N_PHASES;
    hipLaunchKernelGGL(mk_fwd, dim3(grid), dim3(NWAVES * 64), LDS_BYTES, stream, a);
#else
    for (int p = 0; p < N_PHASES; ++p) { a.ph_lo = p; a.ph_hi = p + 1; hipLaunchKernelGGL(mk_fwd, dim3(grid), dim3(NWAVES * 64), LDS_BYTES, stream, a); }
#endif
    const hipError_t le = hipPeekAtLastError();
    if (le != hipSuccess) fprintf(stderr, "kernel_launch: launch failed: %s\n", hipGetErrorName(le));
}
```
